# Optimizing an MI355X kernel written in HIP

```python
import math
import jax, jax.numpy as jnp
from jax import lax
import numpy as np

D_MODEL = 2048
BATCH = 4
SEQ = 4096
DEPTH = 1

D_MIX = D_MODEL
ATTN_WIDTH = D_MIX // 2
SSM_WIDTH = D_MIX - ATTN_WIDTH
ATTN_HEAD_DIM = 64
ATTN_VALUE_DIM = 2 * ATTN_HEAD_DIM
N_ATTN_HEADS = ATTN_WIDTH // ATTN_VALUE_DIM
QK_WIDTH = N_ATTN_HEADS * 2 * ATTN_HEAD_DIM
Q_BLOCK = 128
SUBLN_EPS = 1e-5
SSM_GROUP = 16
N_SSM_GROUPS = SSM_WIDTH // SSM_GROUP
SSM_STATE = 64
DT_MIN = 1e-3
DT_MAX = 1e-1
D_IN_PROJ = 2 * QK_WIDTH + ATTN_WIDTH + SSM_WIDTH
D_FF = 5632
NORM_EPS = 1e-6

kernel_name = "hymba_diffattn_s5_macaron"


def rmsnorm(x, g):
    xf = x.astype(jnp.float32)
    xf = xf * lax.rsqrt(jnp.mean(xf * xf, axis=-1, keepdims=True) + NORM_EPS)
    return (xf * g.astype(jnp.float32)).astype(x.dtype)


def swiglu(h, w_gate, w_up, w_down):
    return (jax.nn.silu(h @ w_gate) * (h @ w_up)) @ w_down


def alibi_slopes(n_heads):
    return jnp.exp2(-8.0 * jnp.arange(1, n_heads + 1, dtype=jnp.float32) / n_heads)


def diff_attention(q, k, v, lam, subln_g, lambda_init):
    b, s, h, _, dh = q.shape
    dv = v.shape[-1]
    n_blocks = s // Q_BLOCK
    q_blocks = jnp.moveaxis(q.reshape(b, n_blocks, Q_BLOCK, h, 2, dh), 1, 0)
    slopes = alibi_slopes(h)
    key_pos = jnp.arange(s)
    scale = dh ** -0.5

    def attend_block(args):
        q_blk, blk = args
        q_pos = blk * Q_BLOCK + jnp.arange(Q_BLOCK)
        scores = jnp.einsum('bqhcd,bkhcd->bhcqk', q_blk, k).astype(jnp.float32) * scale
        dist = (q_pos[:, None] - key_pos[None, :]).astype(jnp.float32)
        scores = scores - slopes[None, :, None, None, None] * dist
        scores = jnp.where(key_pos[None, :] <= q_pos[:, None], scores, -jnp.inf)
        probs = jax.nn.softmax(scores, axis=-1)
        diff = probs[:, :, 0] - lam * probs[:, :, 1]
        return jnp.einsum('bhqk,bkhd->bqhd', diff.astype(v.dtype), v)

    out = lax.map(attend_block, (q_blocks, jnp.arange(n_blocks)))
    out = jnp.moveaxis(out, 0, 1).reshape(b, s, h, dv)
    of = out.astype(jnp.float32)
    of = of * lax.rsqrt(jnp.mean(of * of, axis=-1, keepdims=True) + SUBLN_EPS) * subln_g.astype(jnp.float32)
    of = of * (1.0 - lambda_init)
    return of.astype(v.dtype).reshape(b, s, h * dv)


def ssm_combine(left, right):
    a_re_l, a_im_l, b_re_l, b_im_l = left
    a_re_r, a_im_r, b_re_r, b_im_r = right
    a_re = a_re_r * a_re_l - a_im_r * a_im_l
    a_im = a_re_r * a_im_l + a_im_r * a_re_l
    b_re = a_re_r * b_re_l - a_im_r * b_im_l + b_re_r
    b_im = a_re_r * b_im_l + a_im_r * b_re_l + b_im_r
    return (a_re, a_im, b_re, b_im)


def s5_mixer(u, lam_re, lam_im, log_dt, b_re, b_im, c_re, c_im, d_skip, glu_w, glu_b):
    f32 = jnp.float32
    bsz, s, _ = u.shape
    ug = u.reshape(bsz, s, N_SSM_GROUPS, SSM_GROUP).astype(f32)
    dt = jnp.exp(log_dt.astype(f32))[:, None]
    lr = lam_re.astype(f32)
    li = lam_im.astype(f32)
    mag = jnp.exp(lr * dt)
    ab_re = mag * jnp.cos(li * dt)
    ab_im = mag * jnp.sin(li * dt)
    den = lr * lr + li * li
    f_re = ((ab_re - 1.0) * lr + ab_im * li) / den
    f_im = (ab_im * lr - (ab_re - 1.0) * li) / den
    br = b_re.astype(f32)
    bi = b_im.astype(f32)
    bb_re = f_re[..., None] * br - f_im[..., None] * bi
    bb_im = f_re[..., None] * bi + f_im[..., None] * br
    bu_re = jnp.einsum('bsgh,gph->bsgp', ug, bb_re)
    bu_im = jnp.einsum('bsgh,gph->bsgp', ug, bb_im)
    a_re = jnp.broadcast_to(ab_re[None, None], (1, s, N_SSM_GROUPS, SSM_STATE))
    a_im = jnp.broadcast_to(ab_im[None, None], (1, s, N_SSM_GROUPS, SSM_STATE))
    _, _, x_re, x_im = lax.associative_scan(ssm_combine, (a_re, a_im, bu_re, bu_im), axis=1)
    y = (jnp.einsum('ghp,bsgp->bsgh', c_re.astype(f32), x_re)
         - jnp.einsum('ghp,bsgp->bsgh', c_im.astype(f32), x_im)
         + d_skip.astype(f32).reshape(N_SSM_GROUPS, SSM_GROUP) * ug)
    g = jax.nn.gelu(y.reshape(bsz, s, SSM_WIDTH)).astype(u.dtype)
    return g * jax.nn.sigmoid(g @ glu_w + glu_b)


def setup_inputs(seed: int = 0) -> dict:
    key = jax.random.key(seed)
    ks = jax.random.split(key, 28)
    f32 = jnp.float32
    L = DEPTH
    G, P, HG = N_SSM_GROUPS, SSM_STATE, SSM_GROUP

    def normal(k, shape, scale):
        return jax.random.normal(k, shape, f32) * scale

    def gain(k, shape):
        return 1.0 + 0.02 * jax.random.normal(k, shape, f32)

    n_idx = jnp.arange(P, dtype=f32)
    return {
        "x": normal(ks[0], (BATCH, SEQ, D_MODEL), 1.0),
        "ffn1_norm": gain(ks[1], (L, D_MODEL)),
        "ffn1_w_gate": normal(ks[2], (L, D_MODEL, D_FF), D_MODEL ** -0.5),
        "ffn1_w_up": normal(ks[3], (L, D_MODEL, D_FF), D_MODEL ** -0.5),
        "ffn1_w_down": normal(ks[4], (L, D_FF, D_MODEL), D_FF ** -0.5),
        "mix_norm": gain(ks[5], (L, D_MODEL)),
        "w_in": normal(ks[6], (L, D_MODEL, D_IN_PROJ), D_MODEL ** -0.5),
        "lambda_q1": normal(ks[7], (L, ATTN_HEAD_DIM), 0.1),
        "lambda_k1": normal(ks[8], (L, ATTN_HEAD_DIM), 0.1),
        "lambda_q2": normal(ks[9], (L, ATTN_HEAD_DIM), 0.1),
        "lambda_k2": normal(ks[10], (L, ATTN_HEAD_DIM), 0.1),
        "attn_subln": gain(ks[11], (L, ATTN_VALUE_DIM)),
        "ssm_lambda_re": -0.5 + normal(ks[12], (L, G, P), 0.01),
        "ssm_lambda_im": math.pi * n_idx + normal(ks[13], (L, G, P), 0.01),
        "ssm_log_dt": jax.random.uniform(ks[14], (L, G), f32, math.log(DT_MIN), math.log(DT_MAX)),
        "ssm_b_re": normal(ks[15], (L, G, P, HG), (2 * HG) ** -0.5),
        "ssm_b_im": normal(ks[16], (L, G, P, HG), (2 * HG) ** -0.5),
        "ssm_c_re": normal(ks[17], (L, G, HG, P), P ** -0.5),
        "ssm_c_im": normal(ks[18], (L, G, HG, P), P ** -0.5),
        "ssm_d": normal(ks[19], (L, SSM_WIDTH), 0.5),
        "ssm_glu_w": normal(ks[20], (L, SSM_WIDTH, SSM_WIDTH), SSM_WIDTH ** -0.5),
        "ssm_glu_b": normal(ks[21], (L, SSM_WIDTH), 0.01),
        "w_out": normal(ks[22], (L, D_MIX, D_MODEL), D_MIX ** -0.5),
        "ffn2_norm": gain(ks[23], (L, D_MODEL)),
        "ffn2_w_gate": normal(ks[24], (L, D_MODEL, D_FF), D_MODEL ** -0.5),
        "ffn2_w_up": normal(ks[25], (L, D_MODEL, D_FF), D_MODEL ** -0.5),
        "ffn2_w_down": normal(ks[26], (L, D_FF, D_MODEL), D_FF ** -0.5),
        "final_norm": gain(ks[27], (D_MODEL,)),
    }


def reference(x, ffn1_norm, ffn1_w_gate, ffn1_w_up, ffn1_w_down, mix_norm, w_in,
              lambda_q1, lambda_k1, lambda_q2, lambda_k2, attn_subln,
              ssm_lambda_re, ssm_lambda_im, ssm_log_dt, ssm_b_re, ssm_b_im, ssm_c_re, ssm_c_im,
              ssm_d, ssm_glu_w, ssm_glu_b, w_out,
              ffn2_norm, ffn2_w_gate, ffn2_w_up, ffn2_w_down, final_norm):
    bsz, s, _ = x.shape
    for l in range(DEPTH):
        x = x + 0.5 * swiglu(rmsnorm(x, ffn1_norm[l]), ffn1_w_gate[l], ffn1_w_up[l], ffn1_w_down[l])
        h = rmsnorm(x, mix_norm[l])
        proj = h @ w_in[l]
        q, k, v, u = jnp.split(proj, [QK_WIDTH, 2 * QK_WIDTH, 2 * QK_WIDTH + ATTN_WIDTH], axis=-1)
        q = q.reshape(bsz, s, N_ATTN_HEADS, 2, ATTN_HEAD_DIM)
        k = k.reshape(bsz, s, N_ATTN_HEADS, 2, ATTN_HEAD_DIM)
        v = v.reshape(bsz, s, N_ATTN_HEADS, ATTN_VALUE_DIM)
        lambda_init = 0.8 - 0.6 * math.exp(-0.3 * l)
        lam = (jnp.exp(jnp.sum(lambda_q1[l].astype(jnp.float32) * lambda_k1[l].astype(jnp.float32)))
               - jnp.exp(jnp.sum(lambda_q2[l].astype(jnp.float32) * lambda_k2[l].astype(jnp.float32)))
               + lambda_init)
        attn_out = diff_attention(q, k, v, lam, attn_subln[l], lambda_init)
        ssm_out = s5_mixer(u, ssm_lambda_re[l], ssm_lambda_im[l], ssm_log_dt[l],
                           ssm_b_re[l], ssm_b_im[l], ssm_c_re[l], ssm_c_im[l],
                           ssm_d[l], ssm_glu_w[l], ssm_glu_b[l])
        x = x + jnp.concatenate([attn_out, ssm_out.astype(attn_out.dtype)], axis=-1) @ w_out[l]
        x = x + 0.5 * swiglu(rmsnorm(x, ffn2_norm[l]), ffn2_w_gate[l], ffn2_w_up[l], ffn2_w_down[l])
    return rmsnorm(x, final_norm)
```

```cpp
#include <hip/hip_runtime.h>
#include <hip/hip_cooperative_groups.h>
#include <cstdio>
#include <cstdint>
#include <cmath>
namespace cg = cooperative_groups;
#ifndef PROBE
#define PROBE 0
#endif

#define LAS __attribute__((address_space(3)))
typedef unsigned short bf16_t;
typedef short bf16x8 __attribute__((ext_vector_type(8)));
typedef short s16x4 __attribute__((ext_vector_type(4)));
typedef float f32x2 __attribute__((ext_vector_type(2)));
typedef float f32x4 __attribute__((ext_vector_type(4)));
typedef float f32x16 __attribute__((ext_vector_type(16)));
typedef unsigned u32x2 __attribute__((ext_vector_type(2)));
typedef unsigned u32x4 __attribute__((ext_vector_type(4)));

constexpr int BATCH = 4, SEQ = 4096, DM = 2048, MTOK = BATCH * SEQ, DFF = 5632, DIN = 4096;
constexpr int NGRP = 64, NST = 64, HGC = 16;
constexpr float NORM_EPS = 1e-6f, SUBLN_EPS = 1e-5f;
constexpr float LOG2E = 1.4426950408889634f;
constexpr float QSCALE = 0.125f * LOG2E;
constexpr float LAMBDA_INIT = 0.2f;

__device__ __forceinline__ unsigned cvt_pk_bf16(float lo, float hi) { unsigned r; asm volatile("v_cvt_pk_bf16_f32 %0, %1, %2" : "=v"(r) : "v"(lo), "v"(hi)); return r; }
typedef __bf16 bf16x2_t __attribute__((ext_vector_type(2)));
__device__ __forceinline__ unsigned cvt_pk_bf16_b(float lo, float hi) { const f32x2 v = {lo, hi}; const bf16x2_t b = __builtin_convertvector(v, bf16x2_t); return __builtin_bit_cast(unsigned, b); }
__device__ __forceinline__ float bf16_to_f32(unsigned short v) { return __uint_as_float(((unsigned)v) << 16); }
__device__ __forceinline__ float wave_sum(float v) {
#pragma unroll
    for (int o = 1; o < 64; o <<= 1) v += __shfl_xor(v, o);
    return v;
}

namespace pg8 {
constexpr int BM = 256, BK = 64, HALF = 128, HTB = HALF * BK * 2, STAGE_BYTES = 8 * HTB, NXCD = 8, WGM = 8;
__host__ __device__ __forceinline__ int lds_byte(int r, int c) { const int st = (r >> 4) * 2 + (c >> 5), rr = r & 15, cc = c & 31, ob = rr * 64 + cc * 2; return st * 1024 + (ob ^ (((ob >> 9) & 1) << 5)); }
__host__ __device__ __forceinline__ void stage_rc(int b, int& R, int& C) { const int st = b / 1024, sb = b % 1024, swz = sb ^ (((sb >> 9) & 1) << 5); R = (st >> 1) * 16 + swz / 64; C = (st & 1) * 32 + (swz % 64) / 2; }
__host__ __device__ __forceinline__ int perm32(int rho) { const int n = rho >> 4, i = rho & 15; return 8 * (i >> 2) + 4 * n + (i & 3); }

struct Unit { int pm, pn; };
struct Gemm { const bf16_t* A; const bf16_t* Bt; int M, N, K, lda, ldb; };

struct StaticOrder {
    int nM, nN, nwg, G, c;
    __host__ __device__ void init(int M, int N, int G_, int c_) { nM = M / BM; nN = N / BM; nwg = nM * nN; G = G_; c = c_; }
    __host__ __device__ bool next(int i, Unit& u) const {
        const long L = (long)i * G + c; if (L >= nwg) return false;
        int wgid = (int)L; { const int q = nwg / NXCD, r = nwg % NXCD, xcd = wgid % NXCD, off = wgid / NXCD; wgid = (xcd < r ? xcd * (q + 1) : r * (q + 1) + (xcd - r) * q) + off; }
        const int nig = WGM * nN, gid = wgid / nig, fm = gid * WGM, gsz = (nM - fm) < WGM ? (nM - fm) : WGM;
        u.pm = fm + ((wgid % nig) % gsz); u.pn = (wgid % nig) / gsz; return true;
    }
};


struct EpiSwiGLU {
    static constexpr bool PERM = true;
    bf16_t* O; int ldc; const float* ss;
    __device__ __forceinline__ void operator()(const f32x4 (&acc)[2][2][4][2], const Unit& u, int wr, int wc, int fr, int fq) const {
        const int row0 = u.pm * BM + wr * 64 + fr, col0 = u.pn * HALF + wc * 32 + 8 * fq;
        float rsv[2][4];
#pragma unroll
        for (int ai = 0; ai < 2; ++ai)
#pragma unroll
            for (int m = 0; m < 4; ++m) rsv[ai][m] = ss ? ss[row0 + ai * HALF + m * 16] : 0.f;
#pragma unroll
        for (int ai = 0; ai < 2; ++ai)
#pragma unroll
            for (int m = 0; m < 4; ++m) {
                const int row = row0 + ai * HALF + m * 16;
                const float rs = ss ? rsqrtf(rsv[ai][m] * (1.0f / DM) + NORM_EPS) : 1.0f;
                float o[8];
#pragma unroll
                for (int n = 0; n < 2; ++n)
#pragma unroll
                    for (int j = 0; j < 4; ++j) { const float gt = acc[ai][0][m][n][j] * rs, up = acc[ai][1][m][n][j] * rs;
                        o[n * 4 + j] = gt * __builtin_amdgcn_rcpf(1.0f + __expf(-gt)) * up; }
                u32x4 w; w.x = cvt_pk_bf16(o[0], o[1]); w.y = cvt_pk_bf16(o[2], o[3]); w.z = cvt_pk_bf16(o[4], o[5]); w.w = cvt_pk_bf16(o[6], o[7]);
                *(u32x4*)(O + (size_t)row * ldc + col0) = w;
            }
    }
};
struct EpiResid {
    static constexpr bool PERM = true;
    const float* base; float* out; bf16_t* xb; float* ss; float alpha; LAS float* part;
    __device__ __forceinline__ void operator()(const f32x4 (&acc)[2][2][4][2], const Unit& u, int wr, int wc, int fr, int fq) const {
        const int row0 = u.pm * BM + wr * 64 + fr, col0 = u.pn * BM + wc * 32 + 8 * fq;
#pragma unroll
        for (int ai = 0; ai < 2; ++ai) {
#pragma unroll
          for (int mh = 0; mh < 2; ++mh) {
          f32x4 bb[2][2][2];
#pragma unroll
          for (int m2 = 0; m2 < 2; ++m2)
#pragma unroll
            for (int bj = 0; bj < 2; ++bj) { const size_t off = (size_t)(row0 + ai * HALF + (2 * mh + m2) * 16) * DM + col0 + bj * HALF;
                bb[m2][bj][0] = *(const f32x4*)(base + off); bb[m2][bj][1] = *(const f32x4*)(base + off + 4); }
#pragma unroll
            for (int m2 = 0; m2 < 2; ++m2) { const int m = 2 * mh + m2;
                const int row = row0 + ai * HALF + m * 16; float sq = 0.f;
#pragma unroll
                for (int bj = 0; bj < 2; ++bj) {
                    const size_t off = (size_t)row * DM + col0 + bj * HALF;
                    const f32x4 b0 = bb[m2][bj][0], b1 = bb[m2][bj][1];
                    const f32x4 v0 = b0 + acc[ai][bj][m][0] * alpha, v1 = b1 + acc[ai][bj][m][1] * alpha;
                    *(f32x4*)(out + off) = v0; *(f32x4*)(out + off + 4) = v1;
                    sq += (v0[0] * v0[0] + v0[1] * v0[1]) + (v0[2] * v0[2] + v0[3] * v0[3]) + (v1[0] * v1[0] + v1[1] * v1[1]) + (v1[2] * v1[2] + v1[3] * v1[3]);
                    if (xb) { u32x4 w; w.x = cvt_pk_bf16(v0[0], v0[1]); w.y = cvt_pk_bf16(v0[2], v0[3]); w.z = cvt_pk_bf16(v1[0], v1[1]); w.w = cvt_pk_bf16(v1[2], v1[3]); *(u32x4*)(xb + off) = w; }
                }
                sq += __shfl_xor(sq, 16); sq += __shfl_xor(sq, 32);
                if (fq == 0) part[(row - u.pm * BM) * 4 + wc] = sq;
            }
          }
        }
        asm volatile("s_waitcnt lgkmcnt(0)" ::: "memory"); __builtin_amdgcn_s_barrier();
        { const int t_ = (wr * 4 + wc) * 64 + fq * 16 + fr;
          if (t_ < 256) { const f32x4 p = *(LAS const f32x4*)(part + t_ * 4); atomicAdd(ss + u.pm * BM + t_, (p[0] + p[1]) + (p[2] + p[3])); } }
    }
};
struct EpiWin {
    static constexpr bool PERM = true;
    bf16_t* QKVU; bf16_t* UP; const float* ss; float* knorm2; LAS float* kpart;
    __device__ __forceinline__ void operator()(const f32x4 (&acc)[2][2][4][2], const Unit& u, int wr, int wc, int fr, int fq) const {
        const int row0 = u.pm * BM + wr * 64 + fr, col0 = u.pn * BM + wc * 32 + 8 * fq;
        const float cs = (u.pn < 4) ? QSCALE : 1.0f;
        float rsv[2][4];
#pragma unroll
        for (int ai = 0; ai < 2; ++ai)
#pragma unroll
            for (int m = 0; m < 4; ++m) rsv[ai][m] = ss[row0 + ai * HALF + m * 16];
#pragma unroll
        for (int ai = 0; ai < 2; ++ai)
#pragma unroll
            for (int m = 0; m < 4; ++m) {
                const int row = row0 + ai * HALF + m * 16;
                const float rs = rsqrtf(rsv[ai][m] * (1.0f / DM) + NORM_EPS) * cs;
#pragma unroll
                for (int bj = 0; bj < 2; ++bj) {
                    const f32x4 v0 = acc[ai][bj][m][0] * rs, v1 = acc[ai][bj][m][1] * rs;
                    u32x4 w; w.x = cvt_pk_bf16(v0[0], v0[1]); w.y = cvt_pk_bf16(v0[2], v0[3]); w.z = cvt_pk_bf16(v1[0], v1[1]); w.w = cvt_pk_bf16(v1[2], v1[3]);
                    const int col = col0 + bj * HALF;
                    if (u.pn >= 4 && u.pn < 8) {
                        float sq = (v0[0] * v0[0] + v0[1] * v0[1]) + (v0[2] * v0[2] + v0[3] * v0[3]) + (v1[0] * v1[0] + v1[1] * v1[1]) + (v1[2] * v1[2] + v1[3] * v1[3]);
                        sq += __shfl_xor(sq, 16); sq += __shfl_xor(sq, 32);
                        if (fq == 0) kpart[((row - u.pm * BM) * 4 + 2 * bj + (wc >> 1)) * 2 + (wc & 1)] = sq;
                    }
                    if (u.pn < 12) *(u32x4*)(QKVU + (size_t)row * DIN + col) = w;
                    else { const int cu = col - 3072, g = cu >> 4, ch = cu & 15, b = row >> 12, t = row & 4095;
                           *(u32x4*)(UP + ((size_t)(b * NGRP + g) * SEQ + t) * HGC + ch) = w; }
                }
            }
        if (u.pn >= 4 && u.pn < 8) {
            asm volatile("s_waitcnt lgkmcnt(0)" ::: "memory"); __builtin_amdgcn_s_barrier();
            const int t_ = (wr * 4 + wc) * 64 + fq * 16 + fr, rowb = u.pm * BM;
#pragma unroll
            for (int i = 0; i < 2; ++i) { const int idx = t_ + 512 * i, hcl = idx >> 8, rl = idx & 255;
                const f32x2 p = *(LAS const f32x2*)(kpart + (rl * 4 + hcl) * 2);
                atomicAdd(knorm2 + (size_t)(((rowb + rl) >> 12) * 16 + 4 * (u.pn - 4) + hcl) * SEQ + ((rowb + rl) & 4095), p[0] + p[1]); }
        }
    }
};
struct EpiGlu {
    static constexpr bool PERM = true;
    bf16_t* QKVU; const float* bias;
    __device__ __forceinline__ void operator()(const f32x4 (&acc)[2][2][4][2], const Unit& u, int wr, int wc, int fr, int fq) const {
        const int row0 = u.pm * BM + wr * 64 + fr, col0 = u.pn * BM + wc * 32 + 8 * fq;
        f32x4 bv[2][2];
#pragma unroll
        for (int bj = 0; bj < 2; ++bj) { bv[bj][0] = *(const f32x4*)(bias + col0 + bj * HALF); bv[bj][1] = *(const f32x4*)(bias + col0 + bj * HALF + 4); }
#pragma unroll
        for (int ai = 0; ai < 2; ++ai) {
          u32x4 gwv[4][2];
#pragma unroll
            for (int m = 0; m < 4; ++m)
#pragma unroll
                for (int bj = 0; bj < 2; ++bj) gwv[m][bj] = *(const u32x4*)(QKVU + (size_t)(row0 + ai * HALF + m * 16) * DIN + 3072 + col0 + bj * HALF);
#pragma unroll
            for (int m = 0; m < 4; ++m) {
                const int row = row0 + ai * HALF + m * 16;
#pragma unroll
                for (int bj = 0; bj < 2; ++bj) {
                    const int col = col0 + bj * HALF;
                    const u32x4 gw = gwv[m][bj];
                    const f32x4 b0 = bv[bj][0], b1 = bv[bj][1];
                    float o[8];
#pragma unroll
                    for (int j = 0; j < 4; ++j) {
                        const unsigned gword0 = gw[j >> 1], gword1 = gw[2 + (j >> 1)];
                        const float g0 = (j & 1) ? __uint_as_float(gword0 & 0xffff0000u) : __uint_as_float(gword0 << 16);
                        const float g1 = (j & 1) ? __uint_as_float(gword1 & 0xffff0000u) : __uint_as_float(gword1 << 16);
                        const float z0 = acc[ai][bj][m][0][j] + b0[j], z1 = acc[ai][bj][m][1][j] + b1[j];
                        o[j] = g0 * __builtin_amdgcn_rcpf(1.0f + __expf(-z0)); o[4 + j] = g1 * __builtin_amdgcn_rcpf(1.0f + __expf(-z1));
                    }
                    u32x4 w; w.x = cvt_pk_bf16(o[0], o[1]); w.y = cvt_pk_bf16(o[2], o[3]); w.z = cvt_pk_bf16(o[4], o[5]); w.w = cvt_pk_bf16(o[6], o[7]);
                    *(u32x4*)(QKVU + (size_t)row * DIN + 1024 + col) = w;
                }
            }
        }
    }
};

struct EpiResidNorm {
    static constexpr bool PERM = true;
    const float* base; float* out; float* ss; unsigned* cnt; const float* gain; float alpha; LAS float* part;
    __device__ __forceinline__ void operator()(f32x4 (&acc)[2][2][4][2], const Unit& u, int wr, int wc, int fr, int fq) const {
        const int row0 = u.pm * BM + wr * 64 + fr, col0 = u.pn * BM + wc * 32 + 8 * fq;
#pragma unroll
        for (int ai = 0; ai < 2; ++ai) {
#pragma unroll
          for (int mh = 0; mh < 2; ++mh) {
          f32x4 bb[2][2][2];
#pragma unroll
          for (int m2 = 0; m2 < 2; ++m2)
#pragma unroll
            for (int bj = 0; bj < 2; ++bj) { const size_t off = (size_t)(row0 + ai * HALF + (2 * mh + m2) * 16) * DM + col0 + bj * HALF;
                bb[m2][bj][0] = *(const f32x4*)(base + off); bb[m2][bj][1] = *(const f32x4*)(base + off + 4); }
#pragma unroll
            for (int m2 = 0; m2 < 2; ++m2) { const int m = 2 * mh + m2;
                const int row = row0 + ai * HALF + m * 16; float sq = 0.f;
#pragma unroll
                for (int bj = 0; bj < 2; ++bj) {
                    const f32x4 v0 = bb[m2][bj][0] + acc[ai][bj][m][0] * alpha, v1 = bb[m2][bj][1] + acc[ai][bj][m][1] * alpha;
                    acc[ai][bj][m][0] = v0; acc[ai][bj][m][1] = v1;
                    sq += (v0[0] * v0[0] + v0[1] * v0[1]) + (v0[2] * v0[2] + v0[3] * v0[3]) + (v1[0] * v1[0] + v1[1] * v1[1]) + (v1[2] * v1[2] + v1[3] * v1[3]);
                }
                sq += __shfl_xor(sq, 16); sq += __shfl_xor(sq, 32);
                if (fq == 0) part[(row - u.pm * BM) * 4 + wc] = sq;
            }
          }
        }
        f32x4 gv[2][2];
#pragma unroll
        for (int bj = 0; bj < 2; ++bj) { gv[bj][0] = *(const f32x4*)(gain + col0 + bj * HALF); gv[bj][1] = *(const f32x4*)(gain + col0 + bj * HALF + 4); }
        asm volatile("s_waitcnt lgkmcnt(0)" ::: "memory"); __builtin_amdgcn_s_barrier();
        { const int t_ = (wr * 4 + wc) * 64 + fq * 16 + fr;
          if (t_ < 256) { const f32x4 p = *(LAS const f32x4*)(part + t_ * 4); atomicAdd(ss + u.pm * BM + t_, (p[0] + p[1]) + (p[2] + p[3])); } }
        asm volatile("s_waitcnt vmcnt(0)" ::: "memory");
        __builtin_amdgcn_s_barrier();
        if (wr == 0 && wc == 0) {
            unsigned* c = cnt + 64 * u.pm;
            __builtin_amdgcn_fence(__ATOMIC_RELEASE, "agent");
            asm volatile("s_waitcnt vmcnt(0)" ::: "memory");
            if (fr == 0 && fq == 0) (void)__hip_atomic_fetch_add(c, 1u, __ATOMIC_RELAXED, __HIP_MEMORY_SCOPE_AGENT);
            unsigned sp = 0;
            while (__hip_atomic_load(c, __ATOMIC_RELAXED, __HIP_MEMORY_SCOPE_AGENT) < 8u) { __builtin_amdgcn_s_sleep(8); if (++sp > (1u << 21)) break; }
            __builtin_amdgcn_fence(__ATOMIC_ACQUIRE, "agent");
            asm volatile("s_waitcnt vmcnt(0)" ::: "memory");
        }
        __builtin_amdgcn_s_barrier();
        float rsv[2][4];
#pragma unroll
        for (int ai = 0; ai < 2; ++ai)
#pragma unroll
            for (int m = 0; m < 4; ++m) rsv[ai][m] = __hip_atomic_load(ss + row0 + ai * HALF + m * 16, __ATOMIC_RELAXED, __HIP_MEMORY_SCOPE_AGENT);
#pragma unroll
        for (int ai = 0; ai < 2; ++ai)
#pragma unroll
            for (int m = 0; m < 4; ++m) { const float rs = rsqrtf(rsv[ai][m] * (1.0f / DM) + NORM_EPS);
#pragma unroll
                for (int bj = 0; bj < 2; ++bj) { const size_t off = (size_t)(row0 + ai * HALF + m * 16) * DM + col0 + bj * HALF;
                    *(f32x4*)(out + off) = acc[ai][bj][m][0] * rs * gv[bj][0]; *(f32x4*)(out + off + 4) = acc[ai][bj][m][1] * rs * gv[bj][1]; } }
    }
};
struct FusedOrder {
    int c;
    __host__ __device__ bool next(int i, Unit& u) const { if (i >= 2) return false; u.pm = 32 * i + 4 * (c & 7) + (c >> 6); u.pn = (c >> 3) & 7; return true; }
};

template <class Epi, class Sched, bool ALIGN_EPI = true, bool SP2 = true>
__device__ __forceinline__ void gemm_phase(LAS unsigned char* lds, const Gemm g, const Sched& S, const Epi& E) {
    int tid = threadIdx.x; asm volatile("" : "+v"(tid));
    const int wid = __builtin_amdgcn_readfirstlane(tid >> 6), lane = tid & 63, wr = wid >> 2, wc = wid & 3, fr = lane & 15, fq = lane >> 4;
    const int K = g.K, nt = K / BK;
    unsigned voffA[2], voffB[2];
#pragma unroll
    for (int i = 0; i < 2; ++i) { int R, C; stage_rc(tid * 16 + i * 8192, R, C); const int Rb = Epi::PERM ? ((R & ~31) + perm32(R & 31)) : R;
        voffA[i] = (unsigned)(R * g.lda + C) * 2u; voffB[i] = (unsigned)(Rb * g.ldb + C) * 2u; }
    const size_t kstep = (size_t)(BK * 2);
    const size_t hA = (size_t)HALF * g.lda * 2, hB = (size_t)HALF * g.ldb * 2;
    const size_t tA = 2 * hA, tB = 2 * hB;
    const unsigned ldsw = (unsigned)wid * 1024u;
    const int aoff = lds_byte(wr * 64 + fr, fq * 8), boff = lds_byte(wc * 32 + fr, fq * 8);
#define PG8_SA(b, h) (((b) * 2 + (h)) * HTB)
#define PG8_SB(b, h) ((4 + (b) * 2 + (h)) * HTB)
#define PG8_STAGE(bufoff, gbase, voff) do { _Pragma("unroll") for (int _i = 0; _i < 2; ++_i) \
        __builtin_amdgcn_global_load_lds((const unsigned*)((const char*)(gbase) + (voff)[_i]), (LAS unsigned*)(lds + (bufoff) + ldsw + _i * 8192), 16, 0, 0); } while (0)
#define PG8_LDA(dst, b, h) do { _Pragma("unroll") for (int m = 0; m < 4; ++m) _Pragma("unroll") for (int k = 0; k < 2; ++k) dst[m][k] = *(const LAS bf16x8*)(lds + PG8_SA(b, h) + aoff + m * 2048 + k * 1024); } while (0)
#define PG8_LDB(dst, b, h) do { _Pragma("unroll") for (int n = 0; n < 2; ++n) _Pragma("unroll") for (int k = 0; k < 2; ++k) dst[n][k] = *(const LAS bf16x8*)(lds + PG8_SB(b, h) + boff + n * 2048 + k * 1024); } while (0)
#define PG8_MMA(ai, bj, At, Bt) do { __builtin_amdgcn_s_setprio(1); _Pragma("unroll") for (int m = 0; m < 4; ++m) _Pragma("unroll") for (int n = 0; n < 2; ++n) _Pragma("unroll") for (int k = 0; k < 2; ++k) \
        acc[ai][bj][m][n] = __builtin_amdgcn_mfma_f32_16x16x32_bf16(Bt[n][k], At[m][k], acc[ai][bj][m][n], 0, 0, 0); __builtin_amdgcn_s_setprio(0); } while (0)
#define PG8_WAIT_V(n) asm volatile("s_waitcnt vmcnt(" #n ")" ::: "memory")
#define PG8_WAIT_L(n) asm volatile("s_waitcnt lgkmcnt(" #n ")" ::: "memory")
#define PG8_BAR __builtin_amdgcn_s_barrier()
#define PG8_SCHED __builtin_amdgcn_sched_barrier(0)
    Unit cur, nxt; int ui = 0;
    if (!S.next(0, cur)) return;
    f32x4 acc[2][2][4][2];
#pragma unroll
    for (int a = 0; a < 2; ++a)
#pragma unroll
        for (int b = 0; b < 2; ++b)
#pragma unroll
            for (int m = 0; m < 4; ++m)
#pragma unroll
                for (int n = 0; n < 2; ++n) acc[a][b][m][n] = (f32x4){0.f, 0.f, 0.f, 0.f};
    bf16x8 At[4][2], B0[2][2], B1[2][2];
    const char* cA = (const char*)g.A + (size_t)cur.pm * tA; const char* cB = (const char*)g.Bt + (size_t)cur.pn * tB;
    if constexpr (SP2) {
        PG8_STAGE(PG8_SB(0, 0), cB, voffB); PG8_STAGE(PG8_SB(0, 1), cB + hB, voffB); PG8_STAGE(PG8_SA(0, 0), cA, voffA); PG8_STAGE(PG8_SA(0, 1), cA + hA, voffA);
        if (wr == 1) PG8_BAR;
        PG8_WAIT_V(2); PG8_BAR;
        PG8_STAGE(PG8_SB(1, 0), cB + kstep, voffB); PG8_STAGE(PG8_SA(1, 0), cA + kstep, voffA); PG8_STAGE(PG8_SB(1, 1), cB + hB + kstep, voffB);
        PG8_WAIT_V(6); PG8_BAR;
    } else {
        PG8_STAGE(PG8_SB(0, 0), cB, voffB); PG8_STAGE(PG8_SA(0, 0), cA, voffA); PG8_STAGE(PG8_SB(0, 1), cB + hB, voffB); PG8_STAGE(PG8_SA(0, 1), cA + hA, voffA);
        if (wr == 1) PG8_BAR;
        PG8_WAIT_V(4); PG8_BAR;
        PG8_STAGE(PG8_SB(1, 0), cB + kstep, voffB); PG8_STAGE(PG8_SA(1, 0), cA + kstep, voffA); PG8_STAGE(PG8_SB(1, 1), cB + hB + kstep, voffB);
        PG8_WAIT_V(6); PG8_BAR;
    }
    for (;;) {
        const bool has_next = S.next(ui + 1, nxt);
        const char* nA = has_next ? (const char*)g.A + (size_t)nxt.pm * tA : cA; const char* nB = has_next ? (const char*)g.Bt + (size_t)nxt.pn * tB : cB;
        for (int t = 0; t < nt; t += 2) {
            const bool last = (t == nt - 2);
            const char* a1 = cA + (size_t)(t + 1) * kstep;
            const char* a2 = last ? nA : cA + (size_t)(t + 2) * kstep; const char* b2 = last ? nB : cB + (size_t)(t + 2) * kstep;
            const char* a3 = a2 + kstep; const char* b3 = b2 + kstep;
            if constexpr (SP2) {
            PG8_LDB(B0, 0, 0); PG8_LDB(B1, 0, 1); PG8_SCHED; PG8_LDA(At, 0, 0); PG8_STAGE(PG8_SA(1, 1), a1 + hA, voffA);
            PG8_WAIT_V(8); PG8_WAIT_L(0); PG8_BAR; PG8_MMA(0, 0, At, B0); PG8_MMA(0, 1, At, B1); PG8_BAR; PG8_SCHED;
            PG8_LDA(At, 0, 1); PG8_STAGE(PG8_SB(0, 0), b2, voffB); PG8_STAGE(PG8_SB(0, 1), b2 + hB, voffB); PG8_STAGE(PG8_SA(0, 0), a2, voffA);
            PG8_WAIT_V(8); PG8_WAIT_L(0); PG8_BAR; PG8_MMA(1, 0, At, B0); PG8_MMA(1, 1, At, B1); PG8_BAR; PG8_SCHED;
            PG8_LDB(B0, 1, 0); PG8_LDB(B1, 1, 1); PG8_SCHED; PG8_LDA(At, 1, 0); PG8_STAGE(PG8_SA(0, 1), a2 + hA, voffA);
            PG8_WAIT_V(8); PG8_WAIT_L(0); PG8_BAR; PG8_MMA(0, 0, At, B0); PG8_MMA(0, 1, At, B1); PG8_BAR; PG8_SCHED;
            PG8_LDA(At, 1, 1); PG8_STAGE(PG8_SB(1, 0), b3, voffB); PG8_STAGE(PG8_SB(1, 1), b3 + hB, voffB); PG8_STAGE(PG8_SA(1, 0), a3, voffA);
            PG8_WAIT_V(8); PG8_WAIT_L(0); PG8_BAR; PG8_MMA(1, 0, At, B0); PG8_MMA(1, 1, At, B1); PG8_BAR; PG8_SCHED;
            } else {
            PG8_LDB(B0, 0, 0); PG8_SCHED; PG8_LDA(At, 0, 0); PG8_STAGE(PG8_SA(1, 1), a1 + hA, voffA);
            PG8_WAIT_L(8); PG8_BAR; PG8_WAIT_L(0); PG8_MMA(0, 0, At, B0); PG8_BAR; PG8_SCHED;
            PG8_LDB(B1, 0, 1); PG8_STAGE(PG8_SB(0, 0), b2, voffB);
            PG8_BAR; PG8_WAIT_L(0); PG8_MMA(0, 1, At, B1); PG8_BAR;
            PG8_LDA(At, 0, 1); PG8_STAGE(PG8_SA(0, 0), a2, voffA);
            PG8_BAR; PG8_WAIT_L(0); PG8_MMA(1, 0, At, B0); PG8_BAR; PG8_SCHED;
            PG8_STAGE(PG8_SB(0, 1), b2 + hB, voffB);
            PG8_WAIT_V(6); PG8_BAR; PG8_MMA(1, 1, At, B1); PG8_BAR;
            PG8_LDB(B0, 1, 0); PG8_SCHED; PG8_LDA(At, 1, 0); PG8_STAGE(PG8_SA(0, 1), a2 + hA, voffA);
            PG8_WAIT_L(8); PG8_BAR; PG8_WAIT_L(0); PG8_MMA(0, 0, At, B0); PG8_BAR; PG8_SCHED;
            PG8_LDB(B1, 1, 1); PG8_STAGE(PG8_SB(1, 0), b3, voffB);
            PG8_BAR; PG8_WAIT_L(0); PG8_MMA(0, 1, At, B1); PG8_BAR;
            PG8_LDA(At, 1, 1); PG8_STAGE(PG8_SA(1, 0), a3, voffA);
            PG8_BAR; PG8_WAIT_L(0); PG8_MMA(1, 0, At, B0); PG8_BAR; PG8_SCHED;
            PG8_STAGE(PG8_SB(1, 1), b3 + hB, voffB);
            PG8_WAIT_V(6); PG8_BAR; PG8_MMA(1, 1, At, B1); PG8_BAR;
            }
        }
        if constexpr (ALIGN_EPI) { if (wr == 0) PG8_BAR; }
        E(acc, cur, wr, wc, fr, fq);
        if (!has_next) break;
#pragma unroll
        for (int a = 0; a < 2; ++a)
#pragma unroll
            for (int b = 0; b < 2; ++b)
#pragma unroll
                for (int m = 0; m < 4; ++m)
#pragma unroll
                    for (int n = 0; n < 2; ++n) acc[a][b][m][n] = (f32x4){0.f, 0.f, 0.f, 0.f};
        cur = nxt; cA = nA; cB = nB; ++ui;
        if constexpr (ALIGN_EPI) { if (wr == 1) PG8_BAR; }
    }
    PG8_WAIT_V(0);
    if constexpr (!ALIGN_EPI) { if (wr == 0) PG8_BAR; }
    PG8_BAR;
#undef PG8_SA
#undef PG8_SB
#undef PG8_STAGE
#undef PG8_LDA
#undef PG8_LDB
#undef PG8_MMA
#undef PG8_WAIT_V
#undef PG8_WAIT_L
#undef PG8_BAR
#undef PG8_SCHED
}
}

constexpr size_t MiB = 1u << 20;
constexpr size_t WS_SS1 = 0, WS_SS2 = 65536, WS_SS3 = 131072, WS_A16 = 262144, WS_BAR = 524288, WS_PCNT = 524288 + 16384;
constexpr size_t WS_WGU1 = 1 * MiB, WS_WD1 = 45 * MiB, WS_WIN = 67 * MiB, WS_WGLU = 83 * MiB, WS_WOUT = 85 * MiB, WS_WGU2 = 93 * MiB, WS_WD2 = 137 * MiB;
constexpr size_t WS_TQ = 159 * MiB, WS_PM = 171 * MiB, WS_XN = 175 * MiB, WS_ACT = 239 * MiB, WS_KN = 415 * MiB, WS_END = 416 * MiB;
constexpr size_t WS_QKVU = WS_ACT, WS_UP = WS_ACT + 128 * MiB;
constexpr int LDS_BYTES = 131072 + 16384;

struct Args { const float* in[28]; float* out; unsigned char* ws; int ph_lo, ph_hi; };

__device__ __forceinline__ int drow_map(int n, int mode) { return mode == 0 ? n : ((n >> 7) * 256 + (n & 127) + (mode == 2 ? 128 : 0)); }
__device__ __forceinline__ void tr_item(const float* __restrict__ W, int K, int N, bf16_t* WT, const float* __restrict__ ksc, int mode, LAS float* scr, int item, int lane) {
    const int nblk = N / 32, kb = item / nblk, nb = item % nblk, k0 = 64 * kb, n0 = 32 * nb;
    const int r8 = lane >> 3, c4 = lane & 7;
    f32x4 v[8];
#pragma unroll
    for (int i = 0; i < 8; ++i) v[i] = *(const f32x4*)(W + (size_t)(k0 + 8 * i + r8) * N + n0 + 4 * c4);
    if (ksc) {
#pragma unroll
        for (int i = 0; i < 8; ++i) v[i] = v[i] * ksc[k0 + 8 * i + r8];
    }
#pragma unroll
    for (int i = 0; i < 8; ++i) { LAS float* d = scr + (8 * i + r8) * 33 + 4 * c4; d[0] = v[i][0]; d[1] = v[i][1]; d[2] = v[i][2]; d[3] = v[i][3]; }
    asm volatile("s_waitcnt lgkmcnt(0)" ::: "memory");
    const int c = lane & 7;
#pragma unroll
    for (int j = 0; j < 4; ++j) { const int n = (lane >> 3) + 8 * j; const LAS float* s = scr + (8 * c) * 33 + n;
        u32x4 o; o.x = cvt_pk_bf16(s[0 * 33], s[1 * 33]); o.y = cvt_pk_bf16(s[2 * 33], s[3 * 33]); o.z = cvt_pk_bf16(s[4 * 33], s[5 * 33]); o.w = cvt_pk_bf16(s[6 * 33], s[7 * 33]);
        *(u32x4*)(WT + (size_t)drow_map(n0 + n, mode) * K + k0 + 8 * c) = o; }
    asm volatile("s_waitcnt lgkmcnt(0)" ::: "memory");
}

__device__ __forceinline__ int crow(int r, int hi) { return (r & 3) + 8 * (r >> 2) + 4 * hi; }
__device__ __forceinline__ s16x4 tr_read(LAS const char* p) {
    typedef short v4i16_t __attribute__((ext_vector_type(4)));
    return __builtin_bit_cast(s16x4, __builtin_amdgcn_ds_read_tr16_b64_v4i16((LAS v4i16_t*)p));
}
__device__ __forceinline__ void attn_unit(int b, int h, int qb, const bf16_t* QKVU, bf16_t* Obuf, int ldo, const float* __restrict__ knorm2, LAS unsigned char* lds, float lam, const float* __restrict__ subln_g) {
    const int tid = threadIdx.x, lane = tid & 63, wid = __builtin_amdgcn_readfirstlane(tid >> 6), comp = wid >> 2, qw = wid & 3, r32 = lane & 31, hi = lane >> 5;
    const size_t rowbase = (size_t)b * SEQ;
    const int q0 = qb * 128, qpos = q0 + 32 * qw + r32, qmin = q0 + 32 * qw;
    const bf16_t* Qp = QKVU + (rowbase + qpos) * DIN + h * 128 + comp * 64;
    bf16x8 qr[4];
#pragma unroll
    for (int d0 = 0; d0 < 4; ++d0) qr[d0] = *(const bf16x8*)(Qp + d0 * 16 + hi * 8);
    const float slope2 = exp2f(-(float)(h + 1)) * LOG2E;
    const int NT = 2 * qb + 2;
    const bf16_t* Kg = QKVU + rowbase * DIN + 1024 + h * 128;
    const bf16_t* Vg = QKVU + rowbase * DIN + 2048 + h * 128;
    const int krow = 8 * wid + (lane >> 3), kpc = lane & 7, kchk = kpc ^ ((krow >> 1) & 7);
    const int vrw0 = 4 * wid + (lane >> 4), vrw1 = vrw0 + 32, vpc = lane & 15;
    const int vchk0 = vpc ^ (((vrw0 & 3) << 2) | ((vrw0 >> 2) & 3)), vchk1 = vpc ^ (((vrw1 & 3) << 2) | ((vrw1 >> 2) & 3));
    const bf16_t* ksrc = Kg + (size_t)krow * DIN + kchk * 8;
    const bf16_t* vsrc0 = Vg + (size_t)vrw0 * DIN + vchk0 * 8;
    const bf16_t* vsrc1 = Vg + (size_t)vrw1 * DIN + vchk1 * 8;
#define ATT_DMA(t, buf) do { const size_t go_ = (size_t)(t) * 64 * DIN; LAS unsigned char* sb_ = lds + ((buf) & 3) * 32768 + wid * 1024; \
        __builtin_amdgcn_global_load_lds((const unsigned*)(ksrc + go_), (LAS unsigned*)(sb_), 16, 0, 0); \
        __builtin_amdgcn_global_load_lds((const unsigned*)(ksrc + go_ + 64), (LAS unsigned*)(sb_ + 8192), 16, 0, 0); \
        __builtin_amdgcn_global_load_lds((const unsigned*)(vsrc0 + go_), (LAS unsigned*)(sb_ + 16384), 16, 0, 0); \
        __builtin_amdgcn_global_load_lds((const unsigned*)(vsrc1 + go_), (LAS unsigned*)(sb_ + 24576), 16, 0, 0); } while (0)
    LAS float* red = (LAS float*)(lds + 131072 + 128);
    LAS unsigned* actf = (LAS unsigned*)(lds + 131072 + 256);
    { const float* kn = knorm2 + (size_t)(b * 16 + 2 * h + comp) * SEQ; const int tq = tid & 255; float mx = 0.f;
      f32x4 knv[4];
#pragma unroll
      for (int j = 0; j < 4; ++j) knv[j] = *(const f32x4*)(kn + (j * 256 + tq) * 4);
      ATT_DMA(NT - 1, (NT - 1) & 3); ATT_DMA(NT >= 2 ? NT - 2 : 0, (NT - 2) & 3); ATT_DMA(NT >= 3 ? NT - 3 : 0, (NT - 3) & 3);
#pragma unroll
      for (int j = 0; j < 4; ++j) { const f32x4 v = knv[j]; mx = fmaxf(fmaxf(mx, fmaxf(v[0], v[1])), fmaxf(v[2], v[3])); }
#pragma unroll
      for (int o = 1; o < 64; o <<= 1) mx = fmaxf(mx, __shfl_xor(mx, o));
      if (lane == 0) red[wid] = mx;
      if (tid < 64) actf[tid] = 0u; }
    int vaddr[4][2];
    { const int i16 = lane & 15, q4 = i16 >> 2, p4 = i16 & 3, blk = (lane >> 4) & 1;
#pragma unroll
      for (int dblk = 0; dblk < 4; ++dblk)
#pragma unroll
        for (int ih = 0; ih < 2; ++ih) { const int row = 4 * hi + q4 + 8 * ih, ch = 4 * dblk + 2 * blk + (p4 >> 1), sw = ((row & 3) << 2) | ((row >> 2) & 3);
            vaddr[dblk][ih] = 16384 + row * 256 + ((ch ^ sw) << 4) + 8 * (p4 & 1); } }
    const int kaoff = r32 * 128, ksw = (r32 >> 1) & 7;
    f32x16 o[4];
#pragma unroll
    for (int d = 0; d < 4; ++d)
#pragma unroll
        for (int r = 0; r < 16; ++r) o[d][r] = 0.f;
    float qn = 0.f;
#pragma unroll
    for (int d0 = 0; d0 < 4; ++d0)
#pragma unroll
        for (int j = 0; j < 8; ++j) { const float v = __uint_as_float(((unsigned)(unsigned short)qr[d0][j]) << 16); qn += v * v; }
    qn += __shfl_xor(qn, 32);
    asm volatile("s_waitcnt vmcnt(8) lgkmcnt(0)" ::: "memory");
    __builtin_amdgcn_s_barrier();
    const float kmax = sqrtf(fmaxf(fmaxf(red[4 * comp], red[4 * comp + 1]), fmaxf(red[4 * comp + 2], red[4 * comp + 3])));
    const float bq = sqrtf(qn) * kmax * 1.02f + 1.0f;
    float mrun = 0.f, lrun = 0.f, dq = slope2 * (float)(4 * hi - qpos);
    bool first = true, active = true;
    for (int t = NT - 1; t >= 0; --t) {
        const int buf = t & 3;
        ATT_DMA(t >= 3 ? t - 3 : 0, (t - 3) & 3);
        const int kv0 = t * 64;
        if (active && kv0 <= qmin + 31) {
            const int dmin = qmin - (kv0 + 63);
            if (!first && dmin > 0 && __all((bq - mrun) < slope2 * (float)dmin - 150.0f)) {
                active = false;
            } else {
            LAS const unsigned char* Kb = lds + buf * 32768 + comp * 8192;
            LAS const unsigned char* Sb = lds + buf * 32768;
            f32x16 p0, p1;
            const float dqt = dq + slope2 * (float)kv0;
#pragma unroll
            for (int r = 0; r < 16; ++r) { p0[r] = fmaf(slope2, (float)((r & 3) + 8 * (r >> 2)), dqt); p1[r] = fmaf(slope2, (float)(32 + (r & 3) + 8 * (r >> 2)), dqt); }
            bf16x8 k0f[4], k1f[4];
#pragma unroll
            for (int d0 = 0; d0 < 4; ++d0) {
                const int csw = ((2 * d0 + hi) ^ ksw) << 4;
                k0f[d0] = *(LAS const bf16x8*)(Kb + kaoff + csw);
                k1f[d0] = *(LAS const bf16x8*)(Kb + 4096 + kaoff + csw);
            }
            __builtin_amdgcn_sched_barrier(0);
#pragma unroll
            for (int d0 = 0; d0 < 4; ++d0) {
                p0 = __builtin_amdgcn_mfma_f32_32x32x16_bf16(k0f[d0], qr[d0], p0, 0, 0, 0);
                p1 = __builtin_amdgcn_mfma_f32_32x32x16_bf16(k1f[d0], qr[d0], p1, 0, 0, 0);
            }
            bf16x8 va[4], vb[4];
#define ATT_VREAD(dst, s_) do { _Pragma("unroll") for (int dblk = 0; dblk < 4; ++dblk) { \
                const s16x4 lo_ = tr_read((LAS const char*)(Sb + vaddr[dblk][0] + (s_) * 4096)); const s16x4 hv_ = tr_read((LAS const char*)(Sb + vaddr[dblk][1] + (s_) * 4096)); \
                dst[dblk] = (bf16x8){lo_[0], lo_[1], lo_[2], lo_[3], hv_[0], hv_[1], hv_[2], hv_[3]}; } } while (0)
#define ATT_PV(src, s_) do { _Pragma("unroll") for (int dblk = 0; dblk < 4; ++dblk) o[dblk] = __builtin_amdgcn_mfma_f32_32x32x16_bf16(src[dblk], pf[s_], o[dblk], 0, 0, 0); } while (0)
            ATT_VREAD(va, 0); ATT_VREAD(vb, 1);
            __builtin_amdgcn_sched_barrier(0);
            if (kv0 + 63 > qmin) {
#pragma unroll
                for (int r = 0; r < 16; ++r) { const int kv = kv0 + crow(r, hi); if (kv > qpos) p0[r] = -INFINITY; if (kv + 32 > qpos) p1[r] = -INFINITY; }
            }
            float x = fmaxf(p0[0], p1[0]);
#pragma unroll
            for (int r = 1; r < 16; ++r) x = fmaxf(fmaxf(x, p0[r]), p1[r]);
            x = fmaxf(x, __shfl_xor(x, 32));
            if (first || __any(x > 0.f)) {
                const float xp = first ? x : fmaxf(x, 0.f);
                mrun += xp; dq -= xp;
                const float alpha = __builtin_amdgcn_exp2f(-xp);
                lrun *= alpha;
#pragma unroll
                for (int r = 0; r < 16; ++r) { p0[r] -= xp; p1[r] -= xp; }
                if (!first) {
#pragma unroll
                    for (int d = 0; d < 4; ++d)
#pragma unroll
                        for (int r = 0; r < 16; ++r) o[d][r] *= alpha;
                }
                first = false;
            }
            float sum = 0.f;
#pragma unroll
            for (int r = 0; r < 16; ++r) { p0[r] = __builtin_amdgcn_exp2f(p0[r]); p1[r] = __builtin_amdgcn_exp2f(p1[r]); sum += p0[r] + p1[r]; }
            lrun += sum;
            bf16x8 pf[4];
#pragma unroll
            for (int s = 0; s < 4; ++s) {
                u32x4 w;
                if (s < 2) { w.x = cvt_pk_bf16_b(p0[8 * s + 0], p0[8 * s + 1]); w.y = cvt_pk_bf16_b(p0[8 * s + 2], p0[8 * s + 3]); w.z = cvt_pk_bf16_b(p0[8 * s + 4], p0[8 * s + 5]); w.w = cvt_pk_bf16_b(p0[8 * s + 6], p0[8 * s + 7]); }
                else { const int s2 = s - 2; w.x = cvt_pk_bf16_b(p1[8 * s2 + 0], p1[8 * s2 + 1]); w.y = cvt_pk_bf16_b(p1[8 * s2 + 2], p1[8 * s2 + 3]); w.z = cvt_pk_bf16_b(p1[8 * s2 + 4], p1[8 * s2 + 5]); w.w = cvt_pk_bf16_b(p1[8 * s2 + 6], p1[8 * s2 + 7]); }
                pf[s] = __builtin_bit_cast(bf16x8, w);
            }
            __builtin_amdgcn_sched_barrier(0);
            ATT_PV(va, 0); __builtin_amdgcn_sched_barrier(0);
            ATT_VREAD(va, 2); __builtin_amdgcn_sched_barrier(0);
            ATT_PV(vb, 1); __builtin_amdgcn_sched_barrier(0);
            ATT_VREAD(vb, 3); __builtin_amdgcn_sched_barrier(0);
            ATT_PV(va, 2); __builtin_amdgcn_sched_barrier(0);
            ATT_PV(vb, 3);
#undef ATT_VREAD
#undef ATT_PV
            }
        }
        if (active && lane == 0) actf[t] = 1u;
        asm volatile("s_waitcnt vmcnt(8) lgkmcnt(0)" ::: "memory");
        __builtin_amdgcn_s_barrier();
        if (*(volatile LAS unsigned*)(actf + t) == 0u) break;
    }
#undef ATT_DMA
    lrun += __shfl_xor(lrun, 32);
    const float inv = 1.0f / lrun;
    LAS float* X = (LAS float*)lds;
    asm volatile("s_waitcnt vmcnt(0)" ::: "memory");
    __syncthreads();
    if (comp == 1) {
#pragma unroll
        for (int d = 0; d < 4; ++d)
#pragma unroll
            for (int r = 0; r < 16; ++r) X[(32 * d + crow(r, hi)) * 128 + 32 * qw + r32] = o[d][r] * inv;
    }
    __syncthreads();
    if (comp == 0) {
        float ssq = 0.f;
#pragma unroll
        for (int d = 0; d < 4; ++d)
#pragma unroll
            for (int r = 0; r < 16; ++r) { const float v = o[d][r] * inv - lam * X[(32 * d + crow(r, hi)) * 128 + 32 * qw + r32]; o[d][r] = v; ssq += v * v; }
        ssq += __shfl_xor(ssq, 32);
        const float sc = rsqrtf(ssq * (1.0f / 128.0f) + SUBLN_EPS) * (1.0f - LAMBDA_INIT);
        bf16_t* Op = Obuf + (rowbase + qpos) * (size_t)ldo + h * 128;
        f32x4 g4v[4][4];
#pragma unroll
        for (int d = 0; d < 4; ++d)
#pragma unroll
            for (int rg = 0; rg < 4; ++rg) g4v[d][rg] = *(const f32x4*)(subln_g + 32 * d + 8 * rg + 4 * hi);
#pragma unroll
        for (int d = 0; d < 4; ++d)
#pragma unroll
            for (int rg = 0; rg < 4; ++rg) { const int dd = 32 * d + 8 * rg + 4 * hi; const f32x4 g4 = g4v[d][rg];
                u32x2 w; w.x = cvt_pk_bf16(o[d][4 * rg + 0] * sc * g4[0], o[d][4 * rg + 1] * sc * g4[1]); w.y = cvt_pk_bf16(o[d][4 * rg + 2] * sc * g4[2], o[d][4 * rg + 3] * sc * g4[3]);
                *(u32x2*)(Op + dd) = w; }
    }
    __syncthreads();
}

__device__ __forceinline__ float gelu_tanh(float x) {
    const float z = 0.7978845608028654f * (x + 0.044715f * x * x * x);
    return x * __builtin_amdgcn_rcpf(1.0f + __expf(-2.0f * z));
}
__device__ __forceinline__ void ssm_unit(int b, int g, const bf16_t* __restrict__ UP, const bf16_t* __restrict__ TQ, const bf16_t* __restrict__ PM, const float* __restrict__ A16, bf16_t* QKVU, LAS unsigned char* lds, bool do_store = true) {
    const int tid = threadIdx.x, lane = tid & 63, wid = __builtin_amdgcn_readfirstlane(tid >> 6), r32 = lane & 31, hi = lane >> 5;
    LAS unsigned char* UQ = lds;
    LAS float* XL = (LAS float*)(lds + 33792);
    LAS unsigned char* XI = lds + 66560;
    const bf16_t* Ub = UP + (size_t)(b * NGRP + g) * (SEQ * HGC);
    const bf16_t* TQg = TQ + (size_t)g * 256 * 384;
    const bf16_t* PMg = PM + (size_t)g * 128 * 256;
    const float a16r = A16[(g * NST + lane) * 2], a16i = A16[(g * NST + lane) * 2 + 1];
    const int rb1 = wid >> 2, cb1 = wid & 3;
    bf16x8 tq[16];
    const bf16_t* Tp = TQg + (size_t)(32 * wid + r32) * 384 + 8 * hi;
#pragma unroll
    for (int ks = 0; ks < 16; ++ks) tq[ks] = *(const bf16x8*)(Tp + 16 * ks);
    const bf16_t* Pp = PMg + (size_t)(32 * cb1 + r32) * 256 + 8 * hi;
    float sr = 0.f, si = 0.f;
    u32x4 un[4];
#pragma unroll
    for (int j = 0; j < 4; ++j) un[j] = *(const u32x4*)(Ub + (size_t)(j * 512 + tid) * 8);
    for (int qi = 0; qi < 4; ++qi) {
#pragma unroll
        for (int j = 0; j < 4; ++j) { const int idx = j * 512 + tid, row = idx >> 5, cc = idx & 31; *(LAS u32x4*)(UQ + row * 528 + cc * 16) = un[j]; }
        if (qi < 3) {
#pragma unroll
            for (int j = 0; j < 4; ++j) un[j] = *(const u32x4*)(Ub + (size_t)(qi + 1) * 16384 + (size_t)(j * 512 + tid) * 8);
        }
        bf16x8 pm[16];
#pragma unroll
        for (int ks = 0; ks < 16; ++ks) pm[ks] = *(const bf16x8*)(Pp + 16 * ks);
        __syncthreads();
        { f32x16 acc;
#pragma unroll
          for (int r = 0; r < 16; ++r) acc[r] = 0.f;
#pragma unroll
          for (int ks = 0; ks < 16; ++ks) { const bf16x8 a = *(LAS const bf16x8*)(UQ + (32 * rb1 + r32) * 528 + (16 * ks + 8 * hi) * 2);
              acc = __builtin_amdgcn_mfma_f32_32x32x16_bf16(a, pm[ks], acc, 0, 0, 0); }
#pragma unroll
          for (int r = 0; r < 16; ++r) XL[(32 * rb1 + crow(r, hi)) * 128 + 32 * cb1 + r32] = acc[r]; }
        bf16x8 qf[8];
#pragma unroll
        for (int ks = 0; ks < 8; ++ks) qf[ks] = *(const bf16x8*)(Tp + 256 + 16 * ks);
        __syncthreads();
        if (wid == 0) {
            for (int c0 = 0; c0 < 64; c0 += 8) {
                float xr[8], xi[8];
#pragma unroll
                for (int j = 0; j < 8; ++j) { xr[j] = XL[(c0 + j) * 128 + lane]; xi[j] = XL[(c0 + j) * 128 + 64 + lane]; }
#pragma unroll
                for (int j = 0; j < 8; ++j) {
                    *(LAS unsigned short*)(XI + (c0 + j) * 272 + lane * 2) = (unsigned short)(cvt_pk_bf16(sr, 0.f) & 0xffffu);
                    *(LAS unsigned short*)(XI + (c0 + j) * 272 + 128 + lane * 2) = (unsigned short)(cvt_pk_bf16(si, 0.f) & 0xffffu);
                    const float nr = a16r * sr - a16i * si + xr[j], ni = a16r * si + a16i * sr + xi[j];
                    sr = nr; si = ni;
                }
            }
        }
        __syncthreads();
        { f32x16 acc[2];
#pragma unroll
          for (int rb = 0; rb < 2; ++rb)
#pragma unroll
            for (int r = 0; r < 16; ++r) acc[rb][r] = 0.f;
#pragma unroll
          for (int ks = 0; ks < 16; ++ks) {
#pragma unroll
              for (int rb = 0; rb < 2; ++rb) { const bf16x8 a = *(LAS const bf16x8*)(UQ + (32 * rb + r32) * 528 + (16 * ks + 8 * hi) * 2); acc[rb] = __builtin_amdgcn_mfma_f32_32x32x16_bf16(a, tq[ks], acc[rb], 0, 0, 0); } }
#pragma unroll
          for (int ks = 0; ks < 8; ++ks) {
#pragma unroll
              for (int rb = 0; rb < 2; ++rb) { const bf16x8 a = *(LAS const bf16x8*)(XI + (32 * rb + r32) * 272 + (16 * ks + 8 * hi) * 2); acc[rb] = __builtin_amdgcn_mfma_f32_32x32x16_bf16(a, qf[ks], acc[rb], 0, 0, 0); } }
          LAS unsigned short* YS = (LAS unsigned short*)XL;
#pragma unroll
          for (int rb = 0; rb < 2; ++rb)
#pragma unroll
            for (int r = 0; r < 16; ++r) { const int c = 32 * rb + crow(r, hi);
                const float gv = gelu_tanh(acc[rb][r]);
                YS[c * 256 + 32 * wid + r32] = (unsigned short)(cvt_pk_bf16(gv, 0.f) & 0xffffu); } }
        __syncthreads();
        if (do_store) {
#pragma unroll
        for (int j = 0; j < 4; ++j) { const int id = j * 512 + tid, c = id >> 5, pos = id & 31, tau = pos >> 1, h8 = (pos & 1) * 8;
            const u32x4 v = *(LAS const u32x4*)((LAS const unsigned char*)XL + c * 512 + pos * 16);
            *(u32x4*)(QKVU + ((size_t)b * SEQ + (size_t)(64 * qi + c) * 16 + tau) * DIN + 3072 + g * HGC + h8) = v; }
        }
        __syncthreads();
    }
}

#define XB_TMO      128
#define XB_XCNT(j)  (256  + 64 * (j))
#define XB_XSUB(j)  (1280 + 64 * (j))
#define XB_XGEN(j)  (2304 + 64 * (j))
#define XB_TOP      3328
#define XB_TOPGEN   3392
#define XCD_BAR_WORDS 3456
#define XB_SPIN_CAP (1u << 18)
__device__ __forceinline__ unsigned xb_ld(unsigned* p)              { return __hip_atomic_load(p, __ATOMIC_RELAXED, __HIP_MEMORY_SCOPE_AGENT); }
__device__ __forceinline__ unsigned xb_add(unsigned* p, unsigned v) { return __hip_atomic_fetch_add(p, v, __ATOMIC_RELAXED, __HIP_MEMORY_SCOPE_AGENT); }
__device__ __forceinline__ unsigned xb_xcc_id() { return (unsigned)__builtin_amdgcn_s_getreg((3 << 11) | 20) & 0xFu; }
#define XB_SPIN(cond, bar) do { unsigned _sp = 0; while (cond) { __builtin_amdgcn_s_sleep(1); \
    if ((++_sp & 255u) == 0u) { if (xb_ld(&(bar)[XB_TMO])) break; if (_sp > XB_SPIN_CAP) { atomicAdd(&(bar)[XB_TMO], 1u); break; } } } } while (0)
struct XcdBarrier { unsigned* bar; unsigned x; volatile LAS unsigned* st; };
__device__ __forceinline__ XcdBarrier xcd_barrier_post(unsigned* bar, volatile LAS unsigned* st) {
    XcdBarrier b; b.bar = bar; b.x = xb_xcc_id(); b.st = st;
    if (threadIdx.x == 0) (void)xb_add(&bar[XB_XCNT(b.x)], 1u);
    return b;
}
__device__ __forceinline__ void xcd_barrier_complete(unsigned* bar, unsigned x, unsigned& nloc, unsigned& nx) {
    const unsigned G = gridDim.x * gridDim.y * gridDim.z;
    unsigned sum, cnt, mine, sp = 0u;
    for (;;) {
        sum = 0u; cnt = 0u; mine = 0u;
#pragma unroll
        for (unsigned j = 0; j < 16; ++j) { const unsigned c = xb_ld(&bar[XB_XCNT(j)]); sum += c; cnt += (c > 0u) ? 1u : 0u; mine = (j == x) ? c : mine; }
        if (sum == G) break;
        __builtin_amdgcn_s_sleep(1);
        if ((++sp & 255u) == 0u) { if (xb_ld(&bar[XB_TMO])) break; if (sp > XB_SPIN_CAP) { atomicAdd(&bar[XB_TMO], 1u); break; } }
    }
    nloc = mine > 0u ? mine : 1u; nx = cnt > 0u ? cnt : 1u;
}
__device__ __forceinline__ void xcd_barrier(const XcdBarrier& b) {
    asm volatile("s_waitcnt vmcnt(0)" ::: "memory");
    __syncthreads();
    if (threadIdx.x == 0) {
        unsigned* bar = b.bar;
        __builtin_amdgcn_s_waitcnt(0);
        unsigned nloc = b.st[0], nx = b.st[1];
        if (nloc == 0u) { xcd_barrier_complete(bar, b.x, nloc, nx); b.st[0] = nloc; b.st[1] = nx; }
        const unsigned old = xb_add(&bar[XB_XSUB(b.x)], 1u);
        const unsigned gen = old / nloc;
        if (old + 1u == (gen + 1u) * nloc) {
            __builtin_amdgcn_fence(__ATOMIC_RELEASE, "agent");
            asm volatile("s_waitcnt vmcnt(0)" ::: "memory");
            const unsigned og = xb_add(&bar[XB_TOP], 1u);
            const unsigned tg = og / nx;
            if (og + 1u == (tg + 1u) * nx) xb_add(&bar[XB_TOPGEN], 1u);
            else XB_SPIN(xb_ld(&bar[XB_TOPGEN]) == tg, bar);
            __builtin_amdgcn_fence(__ATOMIC_ACQUIRE, "agent");
            xb_add(&bar[XB_XGEN(b.x)], 1u);
            asm volatile("s_waitcnt vmcnt(0)" ::: "memory");
        } else {
            XB_SPIN(xb_ld(&bar[XB_XGEN(b.x)]) == gen, bar);
            __builtin_amdgcn_fence(__ATOMIC_ACQUIRE, "agent");
            asm volatile("s_waitcnt vmcnt(0)" ::: "memory");
        }
    }
    __syncthreads();
}

static __device__ const unsigned att_tab[64] = {173134591u,155831038u,138527485u,2021260023u,1886515958u,1751771893u,1617027836u,1482283764u,3368634095u,3233891822u,3099149549u,2964407276u,2829667815u,2694925542u,2560183269u,120801252u,2425443551u,2290701278u,103960541u,1345277660u,2155961303u,1210996694u,1076713173u,942429652u,808148943u,673865422u,338124237u,321281228u,304441031u,287598022u,4163069125u,4028785604u,469331391u,452029630u,434727869u,88041404u,400651447u,383349686u,71200693u,54357684u,366050223u,37517230u,20674221u,3831212u,540515239u,406229926u,271944613u,255099812u,240827295u,223523742u,206220189u,188916636u,3900365719u,3765621654u,3630877589u,3496133524u,530250639u,512947086u,495643533u,478339980u,968523655u,833781382u,699039109u,564296836u};

__global__ void __launch_bounds__(512, 2) mk_fwd(Args args) {
    extern __shared__ __attribute__((aligned(16))) unsigned char lds_raw[];
    LAS unsigned char* lds = (LAS unsigned char*)lds_raw;
    cg::grid_group grid = cg::this_grid();
    const int tid = threadIdx.x, lane = tid & 63, wave = __builtin_amdgcn_readfirstlane(tid >> 6);
    const int G = gridDim.x, bx = blockIdx.x;
    const int vcu = (G % 8 == 0) ? (bx % 8) * (G / 8) + bx / 8 : bx;
    unsigned char* ws = args.ws;
    const float* x = args.in[0];
    float* out = args.out;
    float* ss1 = (float*)(ws + WS_SS1); float* ss2 = (float*)(ws + WS_SS2); float* ss3 = (float*)(ws + WS_SS3); float* A16 = (float*)(ws + WS_A16);
    bf16_t* Wgu1 = (bf16_t*)(ws + WS_WGU1); bf16_t* Wd1 = (bf16_t*)(ws + WS_WD1); bf16_t* Win = (bf16_t*)(ws + WS_WIN); bf16_t* Wglu = (bf16_t*)(ws + WS_WGLU);
    bf16_t* Wout = (bf16_t*)(ws + WS_WOUT); bf16_t* Wgu2 = (bf16_t*)(ws + WS_WGU2); bf16_t* Wd2 = (bf16_t*)(ws + WS_WD2);
    bf16_t* TQ = (bf16_t*)(ws + WS_TQ); bf16_t* PM = (bf16_t*)(ws + WS_PM); bf16_t* XN = (bf16_t*)(ws + WS_XN); bf16_t* ACT = (bf16_t*)(ws + WS_ACT);
    bf16_t* QKVU = (bf16_t*)(ws + WS_QKVU); bf16_t* UP = (bf16_t*)(ws + WS_UP); float* KN = (float*)(ws + WS_KN);
    const int lo = args.ph_lo, hi_ph = args.ph_hi;
#define IN(k) (lo <= (k) && (k) < hi_ph)
    volatile LAS unsigned* bst = (volatile LAS unsigned*)(lds + 131072 + 64);
    if (tid < 4) bst[tid] = 0u;
    __syncthreads();
    unsigned* barw = (unsigned*)(ws + WS_BAR);
    if (args.ph_lo < 0) grid.sync();
    XcdBarrier xbar = xcd_barrier_post(barw, bst);
#define SEAM(k) do { if (IN(k) && IN((k) + 1)) xcd_barrier(xbar); } while (0)

    if (IN(0)) {
        { LAS float* scr = (LAS float*)(lds + wave * 8448);
          const int gw = vcu * 8 + wave, NGW = G * 8;
          constexpr int I_F = (DM / 64) * (DFF / 32), I_D = (DFF / 64) * (DM / 32), I_IN = (DM / 64) * (DIN / 32), I_GL = (1024 / 64) * (1024 / 32), I_O = (DM / 64) * (DM / 32);
          constexpr int NITEMS = 4 * I_F + 2 * I_D + I_IN + I_GL + I_O;
          for (int it = gw; it < (PROBE == 3 ? 2 : 1) * NITEMS; it += NGW) {
              int r = it % NITEMS;
              if (r < I_F) { tr_item(args.in[2], DM, DFF, Wgu1, nullptr, 1, scr, r, lane); continue; } r -= I_F;
              if (r < I_F) { tr_item(args.in[3], DM, DFF, Wgu1, nullptr, 2, scr, r, lane); continue; } r -= I_F;
              if (r < I_D) { tr_item(args.in[4], DFF, DM, Wd1, nullptr, 0, scr, r, lane); continue; } r -= I_D;
              if (r < I_IN) { tr_item(args.in[6], DM, DIN, Win, args.in[5], 0, scr, r, lane); continue; } r -= I_IN;
              if (r < I_GL) { tr_item(args.in[20], 1024, 1024, Wglu, nullptr, 0, scr, r, lane); continue; } r -= I_GL;
              if (r < I_O) { tr_item(args.in[22], DM, DM, Wout, nullptr, 0, scr, r, lane); continue; } r -= I_O;
              if (r < I_F) { tr_item(args.in[24], DM, DFF, Wgu2, args.in[23], 1, scr, r, lane); continue; } r -= I_F;
              if (r < I_F) { tr_item(args.in[25], DM, DFF, Wgu2, args.in[23], 2, scr, r, lane); continue; } r -= I_F;
              tr_item(args.in[26], DFF, DM, Wd2, nullptr, 0, scr, r, lane);
          }
          const float* g1 = args.in[1];
          f32x4 g1v[8];
#pragma unroll
          for (int j = 0; j < 8; ++j) g1v[j] = *((const f32x4*)g1 + lane + 64 * j);
          for (int m2 = gw; m2 < (PROBE == 8 ? 2 : 1) * MTOK; m2 += NGW) {
              const int m = m2 % MTOK;
              const f32x4* xr = (const f32x4*)(x + (size_t)m * DM) + lane;
              f32x4 v[8]; float s = 0.f;
#pragma unroll
              for (int j = 0; j < 8; ++j) { v[j] = xr[64 * j]; s += (v[j][0] * v[j][0] + v[j][1] * v[j][1]) + (v[j][2] * v[j][2] + v[j][3] * v[j][3]); }
              const float rs = rsqrtf(wave_sum(s) * (1.0f / DM) + NORM_EPS);
              u32x2* o8 = (u32x2*)(XN + (size_t)m * DM) + lane;
#pragma unroll
              for (int j = 0; j < 8; ++j) { const f32x4 gg = g1v[j]; u32x2 w; w.x = cvt_pk_bf16(v[j][0] * rs * gg[0], v[j][1] * rs * gg[1]); w.y = cvt_pk_bf16(v[j][2] * rs * gg[2], v[j][3] * rs * gg[3]); o8[64 * j] = w; }
          }
        }
        for (int i = bx * 512 + tid; i < 3 * MTOK; i += G * 512) ((float*)(ws + WS_SS1))[i] = 0.f;
        for (int i = bx * 512 + tid; i < BATCH * 16 * SEQ; i += G * 512) KN[i] = 0.f;
        __syncthreads();
        if (bx < 256) {
            const int g = bx & 63, part = bx >> 6;
            LAS float* pwr = (LAS float*)lds; LAS float* pwi = pwr + 17 * 64; LAS float* bbr = pwi + 17 * 64; LAS float* bbi = bbr + 1024; LAS float* crr = bbi + 1024; LAS float* cii = crr + 1024; LAS float* Kd = cii + 1024;
            const float* lam_re = args.in[12] + g * NST; const float* lam_im = args.in[13] + g * NST;
            const float dt = expf(args.in[14][g]);
            for (int idx = tid; idx < 17 * 64; idx += 512) { const int d = idx >> 6, p = idx & 63; const float lr = lam_re[p], li = lam_im[p];
                const float mag = expf((float)d * (lr * dt)), ang = (float)d * (li * dt); pwr[idx] = mag * cosf(ang); pwi[idx] = mag * sinf(ang); }
            for (int idx = tid; idx < 1024; idx += 512) { const int p = idx >> 4; const float lr = lam_re[p], li = lam_im[p];
                const float mag = expf(lr * dt), abr = mag * cosf(li * dt), abi = mag * sinf(li * dt), den = lr * lr + li * li;
                const float fr_ = ((abr - 1.0f) * lr + abi * li) / den, fi_ = (abi * lr - (abr - 1.0f) * li) / den;
                const float br = args.in[15][(size_t)g * 1024 + idx], bi = args.in[16][(size_t)g * 1024 + idx];
                bbr[idx] = fr_ * br - fi_ * bi; bbi[idx] = fr_ * bi + fi_ * br;
                crr[idx] = args.in[17][(size_t)g * 1024 + idx]; cii[idx] = args.in[18][(size_t)g * 1024 + idx]; }
            __syncthreads();
            {
              const int d = tid >> 5, h = (tid >> 1) & 15, hb = (tid & 1) * 8; float acc8[8];
#pragma unroll
              for (int j = 0; j < 8; ++j) acc8[j] = 0.f;
              for (int p = 0; p < 64; ++p) { const float cr = crr[h * 64 + p], ci = cii[h * 64 + p], pr = pwr[d * 64 + p], pi = pwi[d * 64 + p];
                  const float er = cr * pr - ci * pi, ei = cr * pi + ci * pr;
                  const f32x4 br0 = *(LAS const f32x4*)(bbr + p * 16 + hb), br1 = *(LAS const f32x4*)(bbr + p * 16 + hb + 4), bi0 = *(LAS const f32x4*)(bbi + p * 16 + hb), bi1 = *(LAS const f32x4*)(bbi + p * 16 + hb + 4);
#pragma unroll
                  for (int j = 0; j < 4; ++j) { acc8[j] += er * br0[j] - ei * bi0[j]; acc8[4 + j] += er * br1[j] - ei * bi1[j]; } }
#pragma unroll
              for (int j = 0; j < 8; ++j) { float a = acc8[j]; if (d == 0 && h == hb + j) a += args.in[19][g * HGC + h]; Kd[d * 256 + h * 16 + hb + j] = a; } }
            __syncthreads();
            bf16_t* TQg = TQ + (size_t)g * 256 * 384; bf16_t* PMg = PM + (size_t)g * 128 * 256;
            for (int ck = tid; ck < 64 * 48; ck += 512) { const int row = 64 * part + ck / 48, c8 = (ck % 48) * 8, tau = row >> 4, h = row & 15; float v[8];
                if (c8 < 256) { const int sg = c8 >> 4, h2 = c8 & 15;
                    if (tau >= sg) { const f32x4 k0 = *(LAS const f32x4*)(Kd + (tau - sg) * 256 + h * 16 + h2), k1 = *(LAS const f32x4*)(Kd + (tau - sg) * 256 + h * 16 + h2 + 4);
#pragma unroll
                        for (int j = 0; j < 4; ++j) { v[j] = k0[j]; v[4 + j] = k1[j]; } }
                    else {
#pragma unroll
                        for (int j = 0; j < 8; ++j) v[j] = 0.f; } }
                else { const bool im = (c8 >= 320); const int p = c8 - (im ? 320 : 256);
                    const f32x4 cr0 = *(LAS const f32x4*)(crr + h * 64 + p), cr1 = *(LAS const f32x4*)(crr + h * 64 + p + 4), ci0 = *(LAS const f32x4*)(cii + h * 64 + p), ci1 = *(LAS const f32x4*)(cii + h * 64 + p + 4);
                    const f32x4 pr0 = *(LAS const f32x4*)(pwr + (tau + 1) * 64 + p), pr1 = *(LAS const f32x4*)(pwr + (tau + 1) * 64 + p + 4), pi0 = *(LAS const f32x4*)(pwi + (tau + 1) * 64 + p), pi1 = *(LAS const f32x4*)(pwi + (tau + 1) * 64 + p + 4);
#pragma unroll
                    for (int j = 0; j < 4; ++j) { v[j] = im ? -(cr0[j] * pi0[j] + ci0[j] * pr0[j]) : (cr0[j] * pr0[j] - ci0[j] * pi0[j]);
                                                  v[4 + j] = im ? -(cr1[j] * pi1[j] + ci1[j] * pr1[j]) : (cr1[j] * pr1[j] - ci1[j] * pi1[j]); } }
                u32x4 w; w.x = cvt_pk_bf16(v[0], v[1]); w.y = cvt_pk_bf16(v[2], v[3]); w.z = cvt_pk_bf16(v[4], v[5]); w.w = cvt_pk_bf16(v[6], v[7]);
                *(u32x4*)(TQg + (size_t)row * 384 + c8) = w; }
            for (int ck = tid; ck < 32 * 32; ck += 512) { const int row = 32 * part + (ck >> 5), c8 = (ck & 31) * 8, sg = c8 >> 4, h2 = c8 & 15, p = row & 63;
                const float pr = pwr[(15 - sg) * 64 + p], pi = pwi[(15 - sg) * 64 + p];
                const f32x4 br0 = *(LAS const f32x4*)(bbr + p * 16 + h2), br1 = *(LAS const f32x4*)(bbr + p * 16 + h2 + 4), bi0 = *(LAS const f32x4*)(bbi + p * 16 + h2), bi1 = *(LAS const f32x4*)(bbi + p * 16 + h2 + 4);
                float v[8];
#pragma unroll
                for (int j = 0; j < 4; ++j) { v[j] = (row < 64) ? (pr * br0[j] - pi * bi0[j]) : (pr * bi0[j] + pi * br0[j]); v[4 + j] = (row < 64) ? (pr * br1[j] - pi * bi1[j]) : (pr * bi1[j] + pi * br1[j]); }
                u32x4 w; w.x = cvt_pk_bf16(v[0], v[1]); w.y = cvt_pk_bf16(v[2], v[3]); w.z = cvt_pk_bf16(v[4], v[5]); w.w = cvt_pk_bf16(v[6], v[7]);
                *(u32x4*)(PMg + (size_t)row * 256 + c8) = w; }
            if (part == 0 && tid < 64) { A16[(g * NST + tid) * 2] = pwr[16 * 64 + tid]; A16[(g * NST + tid) * 2 + 1] = pwi[16 * 64 + tid]; }
        }
        __syncthreads();
    }
    SEAM(0);
#if PROBE == 4
    for (int i = 0; i < 20; ++i) grid.sync();
#endif
    for (int rep1 = 0; rep1 < (PROBE == 5 ? 2 : 1); ++rep1)
    if (IN(1)) {
        pg8::Gemm g{XN, Wgu1, MTOK, 2 * DFF, DM, DM, DM}; pg8::StaticOrder S; S.init(MTOK, 2 * DFF, G, bx);
        pg8::EpiSwiGLU E{ACT, DFF, nullptr};
        pg8::gemm_phase<pg8::EpiSwiGLU, pg8::StaticOrder>(lds, g, S, E);
    }
    SEAM(1);
    if (IN(2)) {
        pg8::Gemm g{ACT, Wd1, MTOK, DM, DFF, DFF, DFF}; pg8::StaticOrder S; S.init(MTOK, DM, G, bx);
        pg8::EpiResid E{x, out, XN, ss1, 0.5f, (LAS float*)(lds + 131072 + 4096)};
        pg8::gemm_phase<pg8::EpiResid, pg8::StaticOrder>(lds, g, S, E);
    }
    SEAM(2);
    for (int rep3 = 0; rep3 < (PROBE == 7 ? 2 : 1); ++rep3)
    if (IN(3)) {
        pg8::Gemm g{XN, Win, MTOK, DIN, DM, DM, DM}; pg8::StaticOrder S; S.init(MTOK, DIN, G, bx);
        pg8::EpiWin E{QKVU, UP, ss1, KN, (LAS float*)(lds + 131072 + 8192)};
        pg8::gemm_phase<pg8::EpiWin, pg8::StaticOrder>(lds, g, S, E);
    }
    SEAM(3);
    if (IN(4)) {
        float lam;
        { const float a = wave_sum(args.in[7][lane] * args.in[8][lane]), c = wave_sum(args.in[9][lane] * args.in[10][lane]); lam = expf(a) - expf(c) + LAMBDA_INIT; }
        for (int cu = vcu; cu < 256; cu += G) {
            const int b = cu >> 6; const unsigned e = att_tab[cu & 63];
            for (int ui = 0; ui < 4; ++ui) {
                const unsigned u8 = (e >> (8 * ui)) & 255u;
                attn_unit(b, (int)(u8 & 7u), (int)(u8 >> 3), QKVU, QKVU, DIN, KN, lds, lam, args.in[11]);
            }
        }
        if (bx < 256) {
            ssm_unit(bx >> 6, bx & 63, UP, TQ, PM, A16, QKVU, lds, true);
#if PROBE == 2
            ssm_unit(bx >> 6, bx & 63, UP, TQ, PM, A16, QKVU, lds, true);
#endif
#if PROBE == 9
            ssm_unit(bx >> 6, bx & 63, UP, TQ, PM, A16, QKVU, lds, false);
#endif
        }
    }
    SEAM(4);
    for (int rep5 = 0; rep5 < (PROBE == 6 ? 2 : 1); ++rep5)
    if (IN(5)) {
        pg8::Gemm g{QKVU + 3072, Wglu, MTOK, 1024, 1024, DIN, 1024}; pg8::StaticOrder S; S.init(MTOK, 1024, G, bx);
        pg8::EpiGlu E{QKVU, args.in[21]};
        pg8::gemm_phase<pg8::EpiGlu, pg8::StaticOrder>(lds, g, S, E);
    }
    SEAM(5);
    if (IN(6)) {
        pg8::Gemm g{QKVU, Wout, MTOK, DM, DM, DIN, DM}; pg8::StaticOrder S; S.init(MTOK, DM, G, bx);
        pg8::EpiResid E{out, out, XN, ss2, 1.0f, (LAS float*)(lds + 131072 + 4096)};
        pg8::gemm_phase<pg8::EpiResid, pg8::StaticOrder>(lds, g, S, E);
    }
    SEAM(6);
    if (IN(7)) {
        pg8::Gemm g{XN, Wgu2, MTOK, 2 * DFF, DM, DM, DM}; pg8::StaticOrder S; S.init(MTOK, 2 * DFF, G, bx);
        pg8::EpiSwiGLU E{ACT, DFF, ss2};
        pg8::gemm_phase<pg8::EpiSwiGLU, pg8::StaticOrder>(lds, g, S, E);
    }
    SEAM(7);
    const bool fused_tail = (G == 256);
    if (IN(8)) {
        pg8::Gemm g{ACT, Wd2, MTOK, DM, DFF, DFF, DFF};
        if (fused_tail) {
            pg8::FusedOrder S{bx};
            pg8::EpiResidNorm E{out, out, ss3, (unsigned*)(ws + WS_PCNT), args.in[27], 0.5f, (LAS float*)(lds + 131072 + 4096)};
            pg8::gemm_phase<pg8::EpiResidNorm, pg8::FusedOrder>(lds, g, S, E);
        } else {
            pg8::StaticOrder S; S.init(MTOK, DM, G, bx);
            pg8::EpiResid E{out, out, nullptr, ss3, 0.5f, (LAS float*)(lds + 131072 + 4096)};
            pg8::gemm_phase<pg8::EpiResid, pg8::StaticOrder>(lds, g, S, E);
        }
    }
    if (!fused_tail) SEAM(8);
    if (IN(9) && !fused_tail) {
        const float* gf = args.in[27];
        const int gw = vcu * 8 + wave, NGW = G * 8;
        f32x4 ggv[8];
#pragma unroll
        for (int j = 0; j < 8; ++j) ggv[j] = *((const f32x4*)gf + lane + 64 * j);
        for (int m = gw; m < MTOK; m += NGW) {
            const float rs = rsqrtf(ss3[m] * (1.0f / DM) + NORM_EPS);
            f32x4* xr = (f32x4*)(out + (size_t)m * DM) + lane;
            f32x4 v[8];
#pragma unroll
            for (int j = 0; j < 8; ++j) v[j] = xr[64 * j];
#pragma unroll
            for (int j = 0; j < 8; ++j) xr[64 * j] = v[j] * rs * ggv[j];
        }
    }
#undef IN
#undef SEAM
}

#ifndef MK_N_LAUNCHES
#define MK_N_LAUNCHES 1
#endif
constexpr int N_PHASES = 10;

extern "C" void kernel_launch(void* const* d_in, const int* in_sizes, int n_in, void* d_out, int out_size, void* d_ws, size_t ws_size, hipStream_t stream) {
    static int grid = 0;
    if (grid == 0) {
        if (n_in != 28 || ws_size < WS_END) { fprintf(stderr, "kernel_launch: unexpected inputs (n_in %d, ws %zu)\n", n_in, ws_size); grid = -1; return; }
        int dev = 0, cus = 0, per_cu = 0;
        (void)hipGetDevice(&dev);
        (void)hipDeviceGetAttribute(&cus, hipDeviceAttributeMultiprocessorCount, dev);
        (void)hipFuncSetAttribute((const void*)mk_fwd, hipFuncAttributeMaxDynamicSharedMemorySize, LDS_BYTES);
        (void)hipOccupancyMaxActiveBlocksPerMultiprocessor(&per_cu, (const void*)mk_fwd, 512, LDS_BYTES);
        if (per_cu < 1) { fprintf(stderr, "kernel_launch: occupancy query reports %d blocks per CU\n", per_cu); per_cu = 1; }
        (void)hipGetLastError();
        grid = cus;
    }
    if (grid < 0) return;
    if (hipMemsetAsync((char*)d_ws + WS_BAR, 0, 16384 + 64 * 256, stream) != hipSuccess) { fprintf(stderr, "kernel_launch: memset of the barrier words failed\n"); return; }
    Args a{};
    for (int i = 0; i < 28; ++i) a.in[i] = (const float*)d_in[i];
    a.out = (float*)d_out; a.ws = (unsigned char*)d_ws;
#if MK_N_LAUNCHES == 1
    a.ph_lo = 0; a.ph_hi = N_PHASES;
    void* kargs[] = {&a};
    hipError_t e = hipLaunchCooperativeKernel((const void*)mk_fwd, dim3(grid), dim3(512), kargs, LDS_BYTES, stream);
    if (e != hipSuccess) fprintf(stderr, "cooperative launch failed: %s (grid %d)\n", hipGetErrorString(e), grid);
#else
    for (int p = 0; p < N_PHASES; ++p) { a.ph_lo = p; a.ph_hi = p + 1; hipLaunchKernelGGL(mk_fwd, dim3(grid), dim3(512), LDS_BYTES, stream, a); }
#endif
}
```

```cpp
#include <hip/hip_runtime.h>
#include <hip/hip_cooperative_groups.h>
#include <cstdio>
#include <cstdint>
#include <cmath>
namespace cg = cooperative_groups;
#ifndef PROBE
#define PROBE 0
#endif

#define LAS __attribute__((address_space(3)))
typedef unsigned short bf16_t;
typedef short bf16x8 __attribute__((ext_vector_type(8)));
typedef short s16x4 __attribute__((ext_vector_type(4)));
typedef float f32x2 __attribute__((ext_vector_type(2)));
typedef float f32x4 __attribute__((ext_vector_type(4)));
typedef float f32x16 __attribute__((ext_vector_type(16)));
typedef unsigned u32x2 __attribute__((ext_vector_type(2)));
typedef unsigned u32x4 __attribute__((ext_vector_type(4)));

constexpr int BATCH = 4, SEQ = 4096, DM = 2048, MTOK = BATCH * SEQ, DFF = 5632, DIN = 4096;
constexpr int NGRP = 64, NST = 64, HGC = 16;
constexpr float NORM_EPS = 1e-6f, SUBLN_EPS = 1e-5f;
constexpr float LOG2E = 1.4426950408889634f;
constexpr float QSCALE = 0.125f * LOG2E;
constexpr float LAMBDA_INIT = 0.2f;

__device__ __forceinline__ unsigned cvt_pk_bf16(float lo, float hi) { unsigned r; asm volatile("v_cvt_pk_bf16_f32 %0, %1, %2" : "=v"(r) : "v"(lo), "v"(hi)); return r; }
typedef __bf16 bf16x2_t __attribute__((ext_vector_type(2)));
__device__ __forceinline__ unsigned cvt_pk_bf16_b(float lo, float hi) { const f32x2 v = {lo, hi}; const bf16x2_t b = __builtin_convertvector(v, bf16x2_t); return __builtin_bit_cast(unsigned, b); }
__device__ __forceinline__ float bf16_to_f32(unsigned short v) { return __uint_as_float(((unsigned)v) << 16); }
__device__ __forceinline__ float wave_sum(float v) {
#pragma unroll
    for (int o = 1; o < 64; o <<= 1) v += __shfl_xor(v, o);
    return v;
}

namespace pg8 {
constexpr int BM = 256, BK = 64, HALF = 128, HTB = HALF * BK * 2, STAGE_BYTES = 8 * HTB, NXCD = 8, WGM = 8;
__host__ __device__ __forceinline__ int lds_byte(int r, int c) { const int st = (r >> 4) * 2 + (c >> 5), rr = r & 15, cc = c & 31, ob = rr * 64 + cc * 2; return st * 1024 + (ob ^ (((ob >> 9) & 1) << 5)); }
__host__ __device__ __forceinline__ void stage_rc(int b, int& R, int& C) { const int st = b / 1024, sb = b % 1024, swz = sb ^ (((sb >> 9) & 1) << 5); R = (st >> 1) * 16 + swz / 64; C = (st & 1) * 32 + (swz % 64) / 2; }
__host__ __device__ __forceinline__ int perm32(int rho) { const int n = rho >> 4, i = rho & 15; return 8 * (i >> 2) + 4 * n + (i & 3); }

struct Unit { int pm, pn; };
struct Gemm { const bf16_t* A; const bf16_t* Bt; int M, N, K, lda, ldb; };

struct StaticOrder {
    int nM, nN, nwg, G, c;
    __host__ __device__ void init(int M, int N, int G_, int c_) { nM = M / BM; nN = N / BM; nwg = nM * nN; G = G_; c = c_; }
    __host__ __device__ bool next(int i, Unit& u) const {
        const long L = (long)i * G + c; if (L >= nwg) return false;
        int wgid = (int)L; { const int q = nwg / NXCD, r = nwg % NXCD, xcd = wgid % NXCD, off = wgid / NXCD; wgid = (xcd < r ? xcd * (q + 1) : r * (q + 1) + (xcd - r) * q) + off; }
        const int nig = WGM * nN, gid = wgid / nig, fm = gid * WGM, gsz = (nM - fm) < WGM ? (nM - fm) : WGM;
        u.pm = fm + ((wgid % nig) % gsz); u.pn = (wgid % nig) / gsz; return true;
    }
};


struct EpiSwiGLU {
    static constexpr bool PERM = true;
    bf16_t* O; int ldc; const float* ss;
    __device__ __forceinline__ void operator()(const f32x4 (&acc)[2][2][4][2], const Unit& u, int wr, int wc, int fr, int fq) const {
        const int row0 = u.pm * BM + wr * 64 + fr, col0 = u.pn * HALF + wc * 32 + 8 * fq;
        float rsv[2][4];
#pragma unroll
        for (int ai = 0; ai < 2; ++ai)
#pragma unroll
            for (int m = 0; m < 4; ++m) rsv[ai][m] = ss ? ss[row0 + ai * HALF + m * 16] : 0.f;
#pragma unroll
        for (int ai = 0; ai < 2; ++ai)
#pragma unroll
            for (int m = 0; m < 4; ++m) {
                const int row = row0 + ai * HALF + m * 16;
                const float rs = ss ? rsqrtf(rsv[ai][m] * (1.0f / DM) + NORM_EPS) : 1.0f;
                float o[8];
#pragma unroll
                for (int n = 0; n < 2; ++n)
#pragma unroll
                    for (int j = 0; j < 4; ++j) { const float gt = acc[ai][0][m][n][j] * rs, up = acc[ai][1][m][n][j] * rs;
                        o[n * 4 + j] = gt * __builtin_amdgcn_rcpf(1.0f + __expf(-gt)) * up; }
                u32x4 w; w.x = cvt_pk_bf16(o[0], o[1]); w.y = cvt_pk_bf16(o[2], o[3]); w.z = cvt_pk_bf16(o[4], o[5]); w.w = cvt_pk_bf16(o[6], o[7]);
                *(u32x4*)(O + (size_t)row * ldc + col0) = w;
            }
    }
};
struct EpiResid {
    static constexpr bool PERM = true;
    const float* base; float* out; bf16_t* xb; float* ss; float alpha; LAS float* part;
    __device__ __forceinline__ void operator()(const f32x4 (&acc)[2][2][4][2], const Unit& u, int wr, int wc, int fr, int fq) const {
        const int row0 = u.pm * BM + wr * 64 + fr, col0 = u.pn * BM + wc * 32 + 8 * fq;
#pragma unroll
        for (int ai = 0; ai < 2; ++ai) {
#pragma unroll
          for (int mh = 0; mh < 2; ++mh) {
          f32x4 bb[2][2][2];
#pragma unroll
          for (int m2 = 0; m2 < 2; ++m2)
#pragma unroll
            for (int bj = 0; bj < 2; ++bj) { const size_t off = (size_t)(row0 + ai * HALF + (2 * mh + m2) * 16) * DM + col0 + bj * HALF;
                bb[m2][bj][0] = *(const f32x4*)(base + off); bb[m2][bj][1] = *(const f32x4*)(base + off + 4); }
#pragma unroll
            for (int m2 = 0; m2 < 2; ++m2) { const int m = 2 * mh + m2;
                const int row = row0 + ai * HALF + m * 16; float sq = 0.f;
#pragma unroll
                for (int bj = 0; bj < 2; ++bj) {
                    const size_t off = (size_t)row * DM + col0 + bj * HALF;
                    const f32x4 b0 = bb[m2][bj][0], b1 = bb[m2][bj][1];
                    const f32x4 v0 = b0 + acc[ai][bj][m][0] * alpha, v1 = b1 + acc[ai][bj][m][1] * alpha;
                    *(f32x4*)(out + off) = v0; *(f32x4*)(out + off + 4) = v1;
                    sq += (v0[0] * v0[0] + v0[1] * v0[1]) + (v0[2] * v0[2] + v0[3] * v0[3]) + (v1[0] * v1[0] + v1[1] * v1[1]) + (v1[2] * v1[2] + v1[3] * v1[3]);
                    if (xb) { u32x4 w; w.x = cvt_pk_bf16(v0[0], v0[1]); w.y = cvt_pk_bf16(v0[2], v0[3]); w.z = cvt_pk_bf16(v1[0], v1[1]); w.w = cvt_pk_bf16(v1[2], v1[3]); *(u32x4*)(xb + off) = w; }
                }
                sq += __shfl_xor(sq, 16); sq += __shfl_xor(sq, 32);
                if (fq == 0) part[(row - u.pm * BM) * 4 + wc] = sq;
            }
          }
        }
        asm volatile("s_waitcnt lgkmcnt(0)" ::: "memory"); __builtin_amdgcn_s_barrier();
        { const int t_ = (wr * 4 + wc) * 64 + fq * 16 + fr;
          if (t_ < 256) { const f32x4 p = *(LAS const f32x4*)(part + t_ * 4); atomicAdd(ss + u.pm * BM + t_, (p[0] + p[1]) + (p[2] + p[3])); } }
    }
};
struct EpiWin {
    static constexpr bool PERM = true;
    bf16_t* QKVU; bf16_t* UP; const float* ss; float* knorm2; LAS float* kpart;
    __device__ __forceinline__ void operator()(const f32x4 (&acc)[2][2][4][2], const Unit& u, int wr, int wc, int fr, int fq) const {
        const int row0 = u.pm * BM + wr * 64 + fr, col0 = u.pn * BM + wc * 32 + 8 * fq;
        const float cs = (u.pn < 4) ? QSCALE : 1.0f;
        float rsv[2][4];
#pragma unroll
        for (int ai = 0; ai < 2; ++ai)
#pragma unroll
            for (int m = 0; m < 4; ++m) rsv[ai][m] = ss[row0 + ai * HALF + m * 16];
#pragma unroll
        for (int ai = 0; ai < 2; ++ai)
#pragma unroll
            for (int m = 0; m < 4; ++m) {
                const int row = row0 + ai * HALF + m * 16;
                const float rs = rsqrtf(rsv[ai][m] * (1.0f / DM) + NORM_EPS) * cs;
#pragma unroll
                for (int bj = 0; bj < 2; ++bj) {
                    const f32x4 v0 = acc[ai][bj][m][0] * rs, v1 = acc[ai][bj][m][1] * rs;
                    u32x4 w; w.x = cvt_pk_bf16(v0[0], v0[1]); w.y = cvt_pk_bf16(v0[2], v0[3]); w.z = cvt_pk_bf16(v1[0], v1[1]); w.w = cvt_pk_bf16(v1[2], v1[3]);
                    const int col = col0 + bj * HALF;
                    if (u.pn >= 4 && u.pn < 8) {
                        float sq = (v0[0] * v0[0] + v0[1] * v0[1]) + (v0[2] * v0[2] + v0[3] * v0[3]) + (v1[0] * v1[0] + v1[1] * v1[1]) + (v1[2] * v1[2] + v1[3] * v1[3]);
                        sq += __shfl_xor(sq, 16); sq += __shfl_xor(sq, 32);
                        if (fq == 0) kpart[((row - u.pm * BM) * 4 + 2 * bj + (wc >> 1)) * 2 + (wc & 1)] = sq;
                    }
                    if (u.pn < 12) *(u32x4*)(QKVU + (size_t)row * DIN + col) = w;
                    else { const int cu = col - 3072, g = cu >> 4, ch = cu & 15, b = row >> 12, t = row & 4095;
                           *(u32x4*)(UP + ((size_t)(b * NGRP + g) * SEQ + t) * HGC + ch) = w; }
                }
            }
        if (u.pn >= 4 && u.pn < 8) {
            asm volatile("s_waitcnt lgkmcnt(0)" ::: "memory"); __builtin_amdgcn_s_barrier();
            const int t_ = (wr * 4 + wc) * 64 + fq * 16 + fr, rowb = u.pm * BM;
#pragma unroll
            for (int i = 0; i < 2; ++i) { const int idx = t_ + 512 * i, hcl = idx >> 8, rl = idx & 255;
                const f32x2 p = *(LAS const f32x2*)(kpart + (rl * 4 + hcl) * 2);
                atomicAdd(knorm2 + (size_t)(((rowb + rl) >> 12) * 16 + 4 * (u.pn - 4) + hcl) * SEQ + ((rowb + rl) & 4095), p[0] + p[1]); }
        }
    }
};
struct EpiGlu {
    static constexpr bool PERM = true;
    bf16_t* QKVU; const float* bias;
    __device__ __forceinline__ void operator()(const f32x4 (&acc)[2][2][4][2], const Unit& u, int wr, int wc, int fr, int fq) const {
        const int row0 = u.pm * BM + wr * 64 + fr, col0 = u.pn * BM + wc * 32 + 8 * fq;
        f32x4 bv[2][2];
#pragma unroll
        for (int bj = 0; bj < 2; ++bj) { bv[bj][0] = *(const f32x4*)(bias + col0 + bj * HALF); bv[bj][1] = *(const f32x4*)(bias + col0 + bj * HALF + 4); }
#pragma unroll
        for (int ai = 0; ai < 2; ++ai) {
          u32x4 gwv[4][2];
#pragma unroll
            for (int m = 0; m < 4; ++m)
#pragma unroll
                for (int bj = 0; bj < 2; ++bj) gwv[m][bj] = *(const u32x4*)(QKVU + (size_t)(row0 + ai * HALF + m * 16) * DIN + 3072 + col0 + bj * HALF);
#pragma unroll
            for (int m = 0; m < 4; ++m) {
                const int row = row0 + ai * HALF + m * 16;
#pragma unroll
                for (int bj = 0; bj < 2; ++bj) {
                    const int col = col0 + bj * HALF;
                    const u32x4 gw = gwv[m][bj];
                    const f32x4 b0 = bv[bj][0], b1 = bv[bj][1];
                    float o[8];
#pragma unroll
                    for (int j = 0; j < 4; ++j) {
                        const unsigned gword0 = gw[j >> 1], gword1 = gw[2 + (j >> 1)];
                        const float g0 = (j & 1) ? __uint_as_float(gword0 & 0xffff0000u) : __uint_as_float(gword0 << 16);
                        const float g1 = (j & 1) ? __uint_as_float(gword1 & 0xffff0000u) : __uint_as_float(gword1 << 16);
                        const float z0 = acc[ai][bj][m][0][j] + b0[j], z1 = acc[ai][bj][m][1][j] + b1[j];
                        o[j] = g0 * __builtin_amdgcn_rcpf(1.0f + __expf(-z0)); o[4 + j] = g1 * __builtin_amdgcn_rcpf(1.0f + __expf(-z1));
                    }
                    u32x4 w; w.x = cvt_pk_bf16(o[0], o[1]); w.y = cvt_pk_bf16(o[2], o[3]); w.z = cvt_pk_bf16(o[4], o[5]); w.w = cvt_pk_bf16(o[6], o[7]);
                    *(u32x4*)(QKVU + (size_t)row * DIN + 1024 + col) = w;
                }
            }
        }
    }
};

struct EpiResidNorm {
    static constexpr bool PERM = true;
    const float* base; float* out; float* ss; unsigned* cnt; const float* gain; float alpha; LAS float* part;
    __device__ __forceinline__ void operator()(f32x4 (&acc)[2][2][4][2], const Unit& u, int wr, int wc, int fr, int fq) const {
        const int row0 = u.pm * BM + wr * 64 + fr, col0 = u.pn * BM + wc * 32 + 8 * fq;
#pragma unroll
        for (int ai = 0; ai < 2; ++ai) {
#pragma unroll
          for (int mh = 0; mh < 2; ++mh) {
          f32x4 bb[2][2][2];
#pragma unroll
          for (int m2 = 0; m2 < 2; ++m2)
#pragma unroll
            for (int bj = 0; bj < 2; ++bj) { const size_t off = (size_t)(row0 + ai * HALF + (2 * mh + m2) * 16) * DM + col0 + bj * HALF;
                bb[m2][bj][0] = *(const f32x4*)(base + off); bb[m2][bj][1] = *(const f32x4*)(base + off + 4); }
#pragma unroll
            for (int m2 = 0; m2 < 2; ++m2) { const int m = 2 * mh + m2;
                const int row = row0 + ai * HALF + m * 16; float sq = 0.f;
#pragma unroll
                for (int bj = 0; bj < 2; ++bj) {
                    const f32x4 v0 = bb[m2][bj][0] + acc[ai][bj][m][0] * alpha, v1 = bb[m2][bj][1] + acc[ai][bj][m][1] * alpha;
                    acc[ai][bj][m][0] = v0; acc[ai][bj][m][1] = v1;
                    sq += (v0[0] * v0[0] + v0[1] * v0[1]) + (v0[2] * v0[2] + v0[3] * v0[3]) + (v1[0] * v1[0] + v1[1] * v1[1]) + (v1[2] * v1[2] + v1[3] * v1[3]);
                }
                sq += __shfl_xor(sq, 16); sq += __shfl_xor(sq, 32);
                if (fq == 0) part[(row - u.pm * BM) * 4 + wc] = sq;
            }
          }
        }
        f32x4 gv[2][2];
#pragma unroll
        for (int bj = 0; bj < 2; ++bj) { gv[bj][0] = *(const f32x4*)(gain + col0 + bj * HALF); gv[bj][1] = *(const f32x4*)(gain + col0 + bj * HALF + 4); }
        asm volatile("s_waitcnt lgkmcnt(0)" ::: "memory"); __builtin_amdgcn_s_barrier();
        { const int t_ = (wr * 4 + wc) * 64 + fq * 16 + fr;
          if (t_ < 256) { const f32x4 p = *(LAS const f32x4*)(part + t_ * 4); atomicAdd(ss + u.pm * BM + t_, (p[0] + p[1]) + (p[2] + p[3])); } }
        asm volatile("s_waitcnt vmcnt(0)" ::: "memory");
        __builtin_amdgcn_s_barrier();
        if (wr == 0 && wc == 0) {
            unsigned* c = cnt + 64 * u.pm;
            __builtin_amdgcn_fence(__ATOMIC_RELEASE, "agent");
            asm volatile("s_waitcnt vmcnt(0)" ::: "memory");
            if (fr == 0 && fq == 0) (void)__hip_atomic_fetch_add(c, 1u, __ATOMIC_RELAXED, __HIP_MEMORY_SCOPE_AGENT);
            unsigned sp = 0;
            while (__hip_atomic_load(c, __ATOMIC_RELAXED, __HIP_MEMORY_SCOPE_AGENT) < 8u) { __builtin_amdgcn_s_sleep(8); if (++sp > (1u << 21)) break; }
            __builtin_amdgcn_fence(__ATOMIC_ACQUIRE, "agent");
            asm volatile("s_waitcnt vmcnt(0)" ::: "memory");
        }
        __builtin_amdgcn_s_barrier();
        float rsv[2][4];
#pragma unroll
        for (int ai = 0; ai < 2; ++ai)
#pragma unroll
            for (int m = 0; m < 4; ++m) rsv[ai][m] = __hip_atomic_load(ss + row0 + ai * HALF + m * 16, __ATOMIC_RELAXED, __HIP_MEMORY_SCOPE_AGENT);
#pragma unroll
        for (int ai = 0; ai < 2; ++ai)
#pragma unroll
            for (int m = 0; m < 4; ++m) { const float rs = rsqrtf(rsv[ai][m] * (1.0f / DM) + NORM_EPS);
#pragma unroll
                for (int bj = 0; bj < 2; ++bj) { const size_t off = (size_t)(row0 + ai * HALF + m * 16) * DM + col0 + bj * HALF;
                    *(f32x4*)(out + off) = acc[ai][bj][m][0] * rs * gv[bj][0]; *(f32x4*)(out + off + 4) = acc[ai][bj][m][1] * rs * gv[bj][1]; } }
    }
};
struct FusedOrder {
    int c;
    __host__ __device__ bool next(int i, Unit& u) const { if (i >= 2) return false; u.pm = 32 * i + 4 * (c & 7) + (c >> 6); u.pn = (c >> 3) & 7; return true; }
};

template <class Epi, class Sched, bool ALIGN_EPI = true, bool SP2 = true>
__device__ __forceinline__ void gemm_phase(LAS unsigned char* lds, const Gemm g, const Sched& S, const Epi& E) {
    int tid = threadIdx.x; asm volatile("" : "+v"(tid));
    const int wid = __builtin_amdgcn_readfirstlane(tid >> 6), lane = tid & 63, wr = wid >> 2, wc = wid & 3, fr = lane & 15, fq = lane >> 4;
    const int K = g.K, nt = K / BK;
    unsigned voffA[2], voffB[2];
#pragma unroll
    for (int i = 0; i < 2; ++i) { int R, C; stage_rc(tid * 16 + i * 8192, R, C); const int Rb = Epi::PERM ? ((R & ~31) + perm32(R & 31)) : R;
        voffA[i] = (unsigned)(R * g.lda + C) * 2u; voffB[i] = (unsigned)(Rb * g.ldb + C) * 2u; }
    const size_t kstep = (size_t)(BK * 2);
    const size_t hA = (size_t)HALF * g.lda * 2, hB = (size_t)HALF * g.ldb * 2;
    const size_t tA = 2 * hA, tB = 2 * hB;
    const unsigned ldsw = (unsigned)wid * 1024u;
    const int aoff = lds_byte(wr * 64 + fr, fq * 8), boff = lds_byte(wc * 32 + fr, fq * 8);
#define PG8_SA(b, h) (((b) * 2 + (h)) * HTB)
#define PG8_SB(b, h) ((4 + (b) * 2 + (h)) * HTB)
#define PG8_STAGE(bufoff, gbase, voff) do { _Pragma("unroll") for (int _i = 0; _i < 2; ++_i) \
        __builtin_amdgcn_global_load_lds((const unsigned*)((const char*)(gbase) + (voff)[_i]), (LAS unsigned*)(lds + (bufoff) + ldsw + _i * 8192), 16, 0, 0); } while (0)
#define PG8_LDA(dst, b, h) do { _Pragma("unroll") for (int m = 0; m < 4; ++m) _Pragma("unroll") for (int k = 0; k < 2; ++k) dst[m][k] = *(const LAS bf16x8*)(lds + PG8_SA(b, h) + aoff + m * 2048 + k * 1024); } while (0)
#define PG8_LDB(dst, b, h) do { _Pragma("unroll") for (int n = 0; n < 2; ++n) _Pragma("unroll") for (int k = 0; k < 2; ++k) dst[n][k] = *(const LAS bf16x8*)(lds + PG8_SB(b, h) + boff + n * 2048 + k * 1024); } while (0)
#define PG8_MMA(ai, bj, At, Bt) do { __builtin_amdgcn_s_setprio(1); _Pragma("unroll") for (int m = 0; m < 4; ++m) _Pragma("unroll") for (int n = 0; n < 2; ++n) _Pragma("unroll") for (int k = 0; k < 2; ++k) \
        acc[ai][bj][m][n] = __builtin_amdgcn_mfma_f32_16x16x32_bf16(Bt[n][k], At[m][k], acc[ai][bj][m][n], 0, 0, 0); __builtin_amdgcn_s_setprio(0); } while (0)
#define PG8_WAIT_V(n) asm volatile("s_waitcnt vmcnt(" #n ")" ::: "memory")
#define PG8_WAIT_L(n) asm volatile("s_waitcnt lgkmcnt(" #n ")" ::: "memory")
#define PG8_BAR __builtin_amdgcn_s_barrier()
#define PG8_SCHED __builtin_amdgcn_sched_barrier(0)
    Unit cur, nxt; int ui = 0;
    if (!S.next(0, cur)) return;
    f32x4 acc[2][2][4][2];
#pragma unroll
    for (int a = 0; a < 2; ++a)
#pragma unroll
        for (int b = 0; b < 2; ++b)
#pragma unroll
            for (int m = 0; m < 4; ++m)
#pragma unroll
                for (int n = 0; n < 2; ++n) acc[a][b][m][n] = (f32x4){0.f, 0.f, 0.f, 0.f};
    bf16x8 At[4][2], B0[2][2], B1[2][2];
    const char* cA = (const char*)g.A + (size_t)cur.pm * tA; const char* cB = (const char*)g.Bt + (size_t)cur.pn * tB;
    if constexpr (SP2) {
        PG8_STAGE(PG8_SB(0, 0), cB, voffB); PG8_STAGE(PG8_SB(0, 1), cB + hB, voffB); PG8_STAGE(PG8_SA(0, 0), cA, voffA); PG8_STAGE(PG8_SA(0, 1), cA + hA, voffA);
        if (wr == 1) PG8_BAR;
        PG8_WAIT_V(2); PG8_BAR;
        PG8_STAGE(PG8_SB(1, 0), cB + kstep, voffB); PG8_STAGE(PG8_SA(1, 0), cA + kstep, voffA); PG8_STAGE(PG8_SB(1, 1), cB + hB + kstep, voffB);
        PG8_WAIT_V(6); PG8_BAR;
    } else {
        PG8_STAGE(PG8_SB(0, 0), cB, voffB); PG8_STAGE(PG8_SA(0, 0), cA, voffA); PG8_STAGE(PG8_SB(0, 1), cB + hB, voffB); PG8_STAGE(PG8_SA(0, 1), cA + hA, voffA);
        if (wr == 1) PG8_BAR;
        PG8_WAIT_V(4); PG8_BAR;
        PG8_STAGE(PG8_SB(1, 0), cB + kstep, voffB); PG8_STAGE(PG8_SA(1, 0), cA + kstep, voffA); PG8_STAGE(PG8_SB(1, 1), cB + hB + kstep, voffB);
        PG8_WAIT_V(6); PG8_BAR;
    }
    for (;;) {
        const bool has_next = S.next(ui + 1, nxt);
        const char* nA = has_next ? (const char*)g.A + (size_t)nxt.pm * tA : cA; const char* nB = has_next ? (const char*)g.Bt + (size_t)nxt.pn * tB : cB;
        for (int t = 0; t < nt; t += 2) {
            const bool last = (t == nt - 2);
            const char* a1 = cA + (size_t)(t + 1) * kstep;
            const char* a2 = last ? nA : cA + (size_t)(t + 2) * kstep; const char* b2 = last ? nB : cB + (size_t)(t + 2) * kstep;
            const char* a3 = a2 + kstep; const char* b3 = b2 + kstep;
            if constexpr (SP2) {
            PG8_LDB(B0, 0, 0); PG8_LDB(B1, 0, 1); PG8_SCHED; PG8_LDA(At, 0, 0); PG8_STAGE(PG8_SA(1, 1), a1 + hA, voffA);
            PG8_WAIT_V(8); PG8_WAIT_L(0); PG8_BAR; PG8_MMA(0, 0, At, B0); PG8_MMA(0, 1, At, B1); PG8_BAR; PG8_SCHED;
            PG8_LDA(At, 0, 1); PG8_STAGE(PG8_SB(0, 0), b2, voffB); PG8_STAGE(PG8_SB(0, 1), b2 + hB, voffB); PG8_STAGE(PG8_SA(0, 0), a2, voffA);
            PG8_WAIT_V(8); PG8_WAIT_L(0); PG8_BAR; PG8_MMA(1, 0, At, B0); PG8_MMA(1, 1, At, B1); PG8_BAR; PG8_SCHED;
            PG8_LDB(B0, 1, 0); PG8_LDB(B1, 1, 1); PG8_SCHED; PG8_LDA(At, 1, 0); PG8_STAGE(PG8_SA(0, 1), a2 + hA, voffA);
            PG8_WAIT_V(8); PG8_WAIT_L(0); PG8_BAR; PG8_MMA(0, 0, At, B0); PG8_MMA(0, 1, At, B1); PG8_BAR; PG8_SCHED;
            PG8_LDA(At, 1, 1); PG8_STAGE(PG8_SB(1, 0), b3, voffB); PG8_STAGE(PG8_SB(1, 1), b3 + hB, voffB); PG8_STAGE(PG8_SA(1, 0), a3, voffA);
            PG8_WAIT_V(8); PG8_WAIT_L(0); PG8_BAR; PG8_MMA(1, 0, At, B0); PG8_MMA(1, 1, At, B1); PG8_BAR; PG8_SCHED;
            } else {
            PG8_LDB(B0, 0, 0); PG8_SCHED; PG8_LDA(At, 0, 0); PG8_STAGE(PG8_SA(1, 1), a1 + hA, voffA);
            PG8_WAIT_L(8); PG8_BAR; PG8_WAIT_L(0); PG8_MMA(0, 0, At, B0); PG8_BAR; PG8_SCHED;
            PG8_LDB(B1, 0, 1); PG8_STAGE(PG8_SB(0, 0), b2, voffB);
            PG8_BAR; PG8_WAIT_L(0); PG8_MMA(0, 1, At, B1); PG8_BAR;
            PG8_LDA(At, 0, 1); PG8_STAGE(PG8_SA(0, 0), a2, voffA);
            PG8_BAR; PG8_WAIT_L(0); PG8_MMA(1, 0, At, B0); PG8_BAR; PG8_SCHED;
            PG8_STAGE(PG8_SB(0, 1), b2 + hB, voffB);
            PG8_WAIT_V(6); PG8_BAR; PG8_MMA(1, 1, At, B1); PG8_BAR;
            PG8_LDB(B0, 1, 0); PG8_SCHED; PG8_LDA(At, 1, 0); PG8_STAGE(PG8_SA(0, 1), a2 + hA, voffA);
            PG8_WAIT_L(8); PG8_BAR; PG8_WAIT_L(0); PG8_MMA(0, 0, At, B0); PG8_BAR; PG8_SCHED;
            PG8_LDB(B1, 1, 1); PG8_STAGE(PG8_SB(1, 0), b3, voffB);
            PG8_BAR; PG8_WAIT_L(0); PG8_MMA(0, 1, At, B1); PG8_BAR;
            PG8_LDA(At, 1, 1); PG8_STAGE(PG8_SA(1, 0), a3, voffA);
            PG8_BAR; PG8_WAIT_L(0); PG8_MMA(1, 0, At, B0); PG8_BAR; PG8_SCHED;
            PG8_STAGE(PG8_SB(1, 1), b3 + hB, voffB);
            PG8_WAIT_V(6); PG8_BAR; PG8_MMA(1, 1, At, B1); PG8_BAR;
            }
        }
        if constexpr (ALIGN_EPI) { if (wr == 0) PG8_BAR; }
        E(acc, cur, wr, wc, fr, fq);
        if (!has_next) break;
#pragma unroll
        for (int a = 0; a < 2; ++a)
#pragma unroll
            for (int b = 0; b < 2; ++b)
#pragma unroll
                for (int m = 0; m < 4; ++m)
#pragma unroll
                    for (int n = 0; n < 2; ++n) acc[a][b][m][n] = (f32x4){0.f, 0.f, 0.f, 0.f};
        cur = nxt; cA = nA; cB = nB; ++ui;
        if constexpr (ALIGN_EPI) { if (wr == 1) PG8_BAR; }
    }
    PG8_WAIT_V(0);
    if constexpr (!ALIGN_EPI) { if (wr == 0) PG8_BAR; }
    PG8_BAR;
#undef PG8_SA
#undef PG8_SB
#undef PG8_STAGE
#undef PG8_LDA
#undef PG8_LDB
#undef PG8_MMA
#undef PG8_WAIT_V
#undef PG8_WAIT_L
#undef PG8_BAR
#undef PG8_SCHED
}
}

constexpr size_t MiB = 1u << 20;
constexpr size_t WS_SS1 = 0, WS_SS2 = 65536, WS_SS3 = 131072, WS_A16 = 262144, WS_BAR = 524288, WS_PCNT = 524288 + 16384;
constexpr size_t WS_WGU1 = 1 * MiB, WS_WD1 = 45 * MiB, WS_WIN = 67 * MiB, WS_WGLU = 83 * MiB, WS_WOUT = 85 * MiB, WS_WGU2 = 93 * MiB, WS_WD2 = 137 * MiB;
constexpr size_t WS_TQ = 159 * MiB, WS_PM = 171 * MiB, WS_XN = 175 * MiB, WS_ACT = 239 * MiB, WS_KN = 415 * MiB, WS_END = 416 * MiB;
constexpr size_t WS_QKVU = WS_ACT, WS_UP = WS_ACT + 128 * MiB;
constexpr int LDS_BYTES = 131072 + 16384;

struct Args { const float* in[28]; float* out; unsigned char* ws; int ph_lo, ph_hi; };

__device__ __forceinline__ int drow_map(int n, int mode) { return mode == 0 ? n : ((n >> 7) * 256 + (n & 127) + (mode == 2 ? 128 : 0)); }
__device__ __forceinline__ void tr_item(const float* __restrict__ W, int K, int N, bf16_t* WT, const float* __restrict__ ksc, int mode, LAS float* scr, int item, int lane) {
    const int nblk = N / 32, kb = item / nblk, nb = item % nblk, k0 = 64 * kb, n0 = 32 * nb;
    const int r8 = lane >> 3, c4 = lane & 7;
    f32x4 v[8];
#pragma unroll
    for (int i = 0; i < 8; ++i) v[i] = *(const f32x4*)(W + (size_t)(k0 + 8 * i + r8) * N + n0 + 4 * c4);
    if (ksc) {
#pragma unroll
        for (int i = 0; i < 8; ++i) v[i] = v[i] * ksc[k0 + 8 * i + r8];
    }
#pragma unroll
    for (int i = 0; i < 8; ++i) { LAS float* d = scr + (8 * i + r8) * 33 + 4 * c4; d[0] = v[i][0]; d[1] = v[i][1]; d[2] = v[i][2]; d[3] = v[i][3]; }
    asm volatile("s_waitcnt lgkmcnt(0)" ::: "memory");
    const int c = lane & 7;
#pragma unroll
    for (int j = 0; j < 4; ++j) { const int n = (lane >> 3) + 8 * j; const LAS float* s = scr + (8 * c) * 33 + n;
        u32x4 o; o.x = cvt_pk_bf16(s[0 * 33], s[1 * 33]); o.y = cvt_pk_bf16(s[2 * 33], s[3 * 33]); o.z = cvt_pk_bf16(s[4 * 33], s[5 * 33]); o.w = cvt_pk_bf16(s[6 * 33], s[7 * 33]);
        *(u32x4*)(WT + (size_t)drow_map(n0 + n, mode) * K + k0 + 8 * c) = o; }
    asm volatile("s_waitcnt lgkmcnt(0)" ::: "memory");
}

__device__ __forceinline__ int crow(int r, int hi) { return (r & 3) + 8 * (r >> 2) + 4 * hi; }
__device__ __forceinline__ s16x4 tr_read(LAS const char* p) {
    typedef short v4i16_t __attribute__((ext_vector_type(4)));
    return __builtin_bit_cast(s16x4, __builtin_amdgcn_ds_read_tr16_b64_v4i16((LAS v4i16_t*)p));
}
__device__ __forceinline__ void attn_unit(int b, int h, int qb, const bf16_t* QKVU, bf16_t* Obuf, int ldo, const float* __restrict__ knorm2, LAS unsigned char* lds, float lam, const float* __restrict__ subln_g) {
    const int tid = threadIdx.x, lane = tid & 63, wid = __builtin_amdgcn_readfirstlane(tid >> 6), comp = wid >> 2, qw = wid & 3, r32 = lane & 31, hi = lane >> 5;
    const size_t rowbase = (size_t)b * SEQ;
    const int q0 = qb * 128, qpos = q0 + 32 * qw + r32, qmin = q0 + 32 * qw;
    const bf16_t* Qp = QKVU + (rowbase + qpos) * DIN + h * 128 + comp * 64;
    bf16x8 qr[4];
#pragma unroll
    for (int d0 = 0; d0 < 4; ++d0) qr[d0] = *(const bf16x8*)(Qp + d0 * 16 + hi * 8);
    const float slope2 = exp2f(-(float)(h + 1)) * LOG2E;
    const int NT = 2 * qb + 2;
    const bf16_t* Kg = QKVU + rowbase * DIN + 1024 + h * 128;
    const bf16_t* Vg = QKVU + rowbase * DIN + 2048 + h * 128;
    const int krow = 8 * wid + (lane >> 3), kpc = lane & 7, kchk = kpc ^ ((krow >> 1) & 7);
    const int vrw0 = 4 * wid + (lane >> 4), vrw1 = vrw0 + 32, vpc = lane & 15;
    const int vchk0 = vpc ^ (((vrw0 & 3) << 2) | ((vrw0 >> 2) & 3)), vchk1 = vpc ^ (((vrw1 & 3) << 2) | ((vrw1 >> 2) & 3));
    const bf16_t* ksrc = Kg + (size_t)krow * DIN + kchk * 8;
    const bf16_t* vsrc0 = Vg + (size_t)vrw0 * DIN + vchk0 * 8;
    const bf16_t* vsrc1 = Vg + (size_t)vrw1 * DIN + vchk1 * 8;
#define ATT_DMA(t, buf) do { const size_t go_ = (size_t)(t) * 64 * DIN; LAS unsigned char* sb_ = lds + ((buf) & 3) * 32768 + wid * 1024; \
        __builtin_amdgcn_global_load_lds((const unsigned*)(ksrc + go_), (LAS unsigned*)(sb_), 16, 0, 0); \
        __builtin_amdgcn_global_load_lds((const unsigned*)(ksrc + go_ + 64), (LAS unsigned*)(sb_ + 8192), 16, 0, 0); \
        __builtin_amdgcn_global_load_lds((const unsigned*)(vsrc0 + go_), (LAS unsigned*)(sb_ + 16384), 16, 0, 0); \
        __builtin_amdgcn_global_load_lds((const unsigned*)(vsrc1 + go_), (LAS unsigned*)(sb_ + 24576), 16, 0, 0); } while (0)
    LAS float* red = (LAS float*)(lds + 131072 + 128);
    LAS unsigned* actf = (LAS unsigned*)(lds + 131072 + 256);
    { const float* kn = knorm2 + (size_t)(b * 16 + 2 * h + comp) * SEQ; const int tq = tid & 255; float mx = 0.f;
      f32x4 knv[4];
#pragma unroll
      for (int j = 0; j < 4; ++j) knv[j] = *(const f32x4*)(kn + (j * 256 + tq) * 4);
      ATT_DMA(NT - 1, (NT - 1) & 3); ATT_DMA(NT >= 2 ? NT - 2 : 0, (NT - 2) & 3); ATT_DMA(NT >= 3 ? NT - 3 : 0, (NT - 3) & 3);
#pragma unroll
      for (int j = 0; j < 4; ++j) { const f32x4 v = knv[j]; mx = fmaxf(fmaxf(mx, fmaxf(v[0], v[1])), fmaxf(v[2], v[3])); }
#pragma unroll
      for (int o = 1; o < 64; o <<= 1) mx = fmaxf(mx, __shfl_xor(mx, o));
      if (lane == 0) red[wid] = mx;
      if (tid < 64) actf[tid] = 0u; }
    int vaddr[4][2];
    { const int i16 = lane & 15, q4 = i16 >> 2, p4 = i16 & 3, blk = (lane >> 4) & 1;
#pragma unroll
      for (int dblk = 0; dblk < 4; ++dblk)
#pragma unroll
        for (int ih = 0; ih < 2; ++ih) { const int row = 4 * hi + q4 + 8 * ih, ch = 4 * dblk + 2 * blk + (p4 >> 1), sw = ((row & 3) << 2) | ((row >> 2) & 3);
            vaddr[dblk][ih] = 16384 + row * 256 + ((ch ^ sw) << 4) + 8 * (p4 & 1); } }
    const int kaoff = r32 * 128, ksw = (r32 >> 1) & 7;
    f32x16 o[4];
#pragma unroll
    for (int d = 0; d < 4; ++d)
#pragma unroll
        for (int r = 0; r < 16; ++r) o[d][r] = 0.f;
    float qn = 0.f;
#pragma unroll
    for (int d0 = 0; d0 < 4; ++d0)
#pragma unroll
        for (int j = 0; j < 8; ++j) { const float v = __uint_as_float(((unsigned)(unsigned short)qr[d0][j]) << 16); qn += v * v; }
    qn += __shfl_xor(qn, 32);
    asm volatile("s_waitcnt vmcnt(8) lgkmcnt(0)" ::: "memory");
    __builtin_amdgcn_s_barrier();
    const float kmax = sqrtf(fmaxf(fmaxf(red[4 * comp], red[4 * comp + 1]), fmaxf(red[4 * comp + 2], red[4 * comp + 3])));
    const float bq = sqrtf(qn) * kmax * 1.02f + 1.0f;
    float mrun = 0.f, lrun = 0.f, dq = slope2 * (float)(4 * hi - qpos);
    bool first = true, active = true;
    for (int t = NT - 1; t >= 0; --t) {
        const int buf = t & 3;
        ATT_DMA(t >= 3 ? t - 3 : 0, (t - 3) & 3);
        const int kv0 = t * 64;
        if (active && kv0 <= qmin + 31) {
            const int dmin = qmin - (kv0 + 63);
            if (!first && dmin > 0 && __all((bq - mrun) < slope2 * (float)dmin - 150.0f)) {
                active = false;
            } else {
            LAS const unsigned char* Kb = lds + buf * 32768 + comp * 8192;
            LAS const unsigned char* Sb = lds + buf * 32768;
            f32x16 p0, p1;
            const float dqt = dq + slope2 * (float)kv0;
#pragma unroll
            for (int r = 0; r < 16; ++r) { p0[r] = fmaf(slope2, (float)((r & 3) + 8 * (r >> 2)), dqt); p1[r] = fmaf(slope2, (float)(32 + (r & 3) + 8 * (r >> 2)), dqt); }
            bf16x8 k0f[4], k1f[4];
#pragma unroll
            for (int d0 = 0; d0 < 4; ++d0) {
                const int csw = ((2 * d0 + hi) ^ ksw) << 4;
                k0f[d0] = *(LAS const bf16x8*)(Kb + kaoff + csw);
                k1f[d0] = *(LAS const bf16x8*)(Kb + 4096 + kaoff + csw);
            }
            __builtin_amdgcn_sched_barrier(0);
#pragma unroll
            for (int d0 = 0; d0 < 4; ++d0) {
                p0 = __builtin_amdgcn_mfma_f32_32x32x16_bf16(k0f[d0], qr[d0], p0, 0, 0, 0);
                p1 = __builtin_amdgcn_mfma_f32_32x32x16_bf16(k1f[d0], qr[d0], p1, 0, 0, 0);
            }
            bf16x8 va[4], vb[4];
#define ATT_VREAD(dst, s_) do { _Pragma("unroll") for (int dblk = 0; dblk < 4; ++dblk) { \
                const s16x4 lo_ = tr_read((LAS const char*)(Sb + vaddr[dblk][0] + (s_) * 4096)); const s16x4 hv_ = tr_read((LAS const char*)(Sb + vaddr[dblk][1] + (s_) * 4096)); \
                dst[dblk] = (bf16x8){lo_[0], lo_[1], lo_[2], lo_[3], hv_[0], hv_[1], hv_[2], hv_[3]}; } } while (0)
#define ATT_PV(src, s_) do { _Pragma("unroll") for (int dblk = 0; dblk < 4; ++dblk) o[dblk] = __builtin_amdgcn_mfma_f32_32x32x16_bf16(src[dblk], pf[s_], o[dblk], 0, 0, 0); } while (0)
            ATT_VREAD(va, 0); ATT_VREAD(vb, 1);
            __builtin_amdgcn_sched_barrier(0);
            if (kv0 + 63 > qmin) {
#pragma unroll
                for (int r = 0; r < 16; ++r) { const int kv = kv0 + crow(r, hi); if (kv > qpos) p0[r] = -INFINITY; if (kv + 32 > qpos) p1[r] = -INFINITY; }
            }
            float x = fmaxf(p0[0], p1[0]);
#pragma unroll
            for (int r = 1; r < 16; ++r) x = fmaxf(fmaxf(x, p0[r]), p1[r]);
            x = fmaxf(x, __shfl_xor(x, 32));
            if (first || __any(x > 0.f)) {
                const float xp = first ? x : fmaxf(x, 0.f);
                mrun += xp; dq -= xp;
                const float alpha = __builtin_amdgcn_exp2f(-xp);
                lrun *= alpha;
#pragma unroll
                for (int r = 0; r < 16; ++r) { p0[r] -= xp; p1[r] -= xp; }
                if (!first) {
#pragma unroll
                    for (int d = 0; d < 4; ++d)
#pragma unroll
                        for (int r = 0; r < 16; ++r) o[d][r] *= alpha;
                }
                first = false;
            }
            float sum = 0.f;
#pragma unroll
            for (int r = 0; r < 16; ++r) { p0[r] = __builtin_amdgcn_exp2f(p0[r]); p1[r] = __builtin_amdgcn_exp2f(p1[r]); sum += p0[r] + p1[r]; }
            lrun += sum;
            bf16x8 pf[4];
#pragma unroll
            for (int s = 0; s < 4; ++s) {
                u32x4 w;
                if (s < 2) { w.x = cvt_pk_bf16_b(p0[8 * s + 0], p0[8 * s + 1]); w.y = cvt_pk_bf16_b(p0[8 * s + 2], p0[8 * s + 3]); w.z = cvt_pk_bf16_b(p0[8 * s + 4], p0[8 * s + 5]); w.w = cvt_pk_bf16_b(p0[8 * s + 6], p0[8 * s + 7]); }
                else { const int s2 = s - 2; w.x = cvt_pk_bf16_b(p1[8 * s2 + 0], p1[8 * s2 + 1]); w.y = cvt_pk_bf16_b(p1[8 * s2 + 2], p1[8 * s2 + 3]); w.z = cvt_pk_bf16_b(p1[8 * s2 + 4], p1[8 * s2 + 5]); w.w = cvt_pk_bf16_b(p1[8 * s2 + 6], p1[8 * s2 + 7]); }
                pf[s] = __builtin_bit_cast(bf16x8, w);
            }
            __builtin_amdgcn_sched_barrier(0);
            ATT_PV(va, 0); __builtin_amdgcn_sched_barrier(0);
            ATT_VREAD(va, 2); __builtin_amdgcn_sched_barrier(0);
            ATT_PV(vb, 1); __builtin_amdgcn_sched_barrier(0);
            ATT_VREAD(vb, 3); __builtin_amdgcn_sched_barrier(0);
            ATT_PV(va, 2); __builtin_amdgcn_sched_barrier(0);
            ATT_PV(vb, 3);
#undef ATT_VREAD
#undef ATT_PV
            }
        }
        if (active && lane == 0) actf[t] = 1u;
        asm volatile("s_waitcnt vmcnt(8) lgkmcnt(0)" ::: "memory");
        __builtin_amdgcn_s_barrier();
        if (*(volatile LAS unsigned*)(actf + t) == 0u) break;
    }
#undef ATT_DMA
    lrun += __shfl_xor(lrun, 32);
    const float inv = 1.0f / lrun;
    LAS float* X = (LAS float*)lds;
    asm volatile("s_waitcnt vmcnt(0)" ::: "memory");
    __syncthreads();
    if (comp == 1) {
#pragma unroll
        for (int d = 0; d < 4; ++d)
#pragma unroll
            for (int r = 0; r < 16; ++r) X[(32 * d + crow(r, hi)) * 128 + 32 * qw + r32] = o[d][r] * inv;
    }
    __syncthreads();
    if (comp == 0) {
        float ssq = 0.f;
#pragma unroll
        for (int d = 0; d < 4; ++d)
#pragma unroll
            for (int r = 0; r < 16; ++r) { const float v = o[d][r] * inv - lam * X[(32 * d + crow(r, hi)) * 128 + 32 * qw + r32]; o[d][r] = v; ssq += v * v; }
        ssq += __shfl_xor(ssq, 32);
        const float sc = rsqrtf(ssq * (1.0f / 128.0f) + SUBLN_EPS) * (1.0f - LAMBDA_INIT);
        bf16_t* Op = Obuf + (rowbase + qpos) * (size_t)ldo + h * 128;
        f32x4 g4v[4][4];
#pragma unroll
        for (int d = 0; d < 4; ++d)
#pragma unroll
            for (int rg = 0; rg < 4; ++rg) g4v[d][rg] = *(const f32x4*)(subln_g + 32 * d + 8 * rg + 4 * hi);
#pragma unroll
        for (int d = 0; d < 4; ++d)
#pragma unroll
            for (int rg = 0; rg < 4; ++rg) { const int dd = 32 * d + 8 * rg + 4 * hi; const f32x4 g4 = g4v[d][rg];
                u32x2 w; w.x = cvt_pk_bf16(o[d][4 * rg + 0] * sc * g4[0], o[d][4 * rg + 1] * sc * g4[1]); w.y = cvt_pk_bf16(o[d][4 * rg + 2] * sc * g4[2], o[d][4 * rg + 3] * sc * g4[3]);
                *(u32x2*)(Op + dd) = w; }
    }
    __syncthreads();
}

__device__ __forceinline__ float gelu_tanh(float x) {
    const float z = 0.7978845608028654f * (x + 0.044715f * x * x * x);
    return x * __builtin_amdgcn_rcpf(1.0f + __expf(-2.0f * z));
}
__device__ __forceinline__ void ssm_unit(int b, int g, const bf16_t* __restrict__ UP, const bf16_t* __restrict__ TQ, const bf16_t* __restrict__ PM, const float* __restrict__ A16, bf16_t* QKVU, LAS unsigned char* lds, bool do_store = true) {
    const int tid = threadIdx.x, lane = tid & 63, wid = __builtin_amdgcn_readfirstlane(tid >> 6), r32 = lane & 31, hi = lane >> 5;
    LAS unsigned char* UQ = lds;
    LAS float* XL = (LAS float*)(lds + 33792);
    LAS unsigned char* XI = lds + 66560;
    const bf16_t* Ub = UP + (size_t)(b * NGRP + g) * (SEQ * HGC);
    const bf16_t* TQg = TQ + (size_t)g * 256 * 384;
    const bf16_t* PMg = PM + (size_t)g * 128 * 256;
    const float a16r = A16[(g * NST + lane) * 2], a16i = A16[(g * NST + lane) * 2 + 1];
    const int rb1 = wid >> 2, cb1 = wid & 3;
    bf16x8 tq[16];
    const bf16_t* Tp = TQg + (size_t)(32 * wid + r32) * 384 + 8 * hi;
#pragma unroll
    for (int ks = 0; ks < 16; ++ks) tq[ks] = *(const bf16x8*)(Tp + 16 * ks);
    const bf16_t* Pp = PMg + (size_t)(32 * cb1 + r32) * 256 + 8 * hi;
    float sr = 0.f, si = 0.f;
    for (int qi = 0; qi < 4; ++qi) {
        { u32x4 un[4];
#pragma unroll
          for (int j = 0; j < 4; ++j) un[j] = *(const u32x4*)(Ub + (size_t)qi * 16384 + (size_t)(j * 512 + tid) * 8);
#pragma unroll
          for (int j = 0; j < 4; ++j) { const int idx = j * 512 + tid, row = idx >> 5, cc = idx & 31; *(LAS u32x4*)(UQ + row * 528 + cc * 16) = un[j]; } }
        bf16x8 pm[16];
#pragma unroll
        for (int ks = 0; ks < 16; ++ks) pm[ks] = *(const bf16x8*)(Pp + 16 * ks);
        __syncthreads();
        { f32x16 acc;
#pragma unroll
          for (int r = 0; r < 16; ++r) acc[r] = 0.f;
          LAS const unsigned char* ua = UQ + (32 * rb1 + r32) * 528 + 16 * hi;
          bf16x8 fa[4];
#define SSM_XLD(dst, g_) do { _Pragma("unroll") for (int i_ = 0; i_ < 4; ++i_) dst[i_] = *(LAS const bf16x8*)(ua + 32 * (4 * (g_) + i_)); } while (0)
#define SSM_XMM(src, g_) do { _Pragma("unroll") for (int i_ = 0; i_ < 4; ++i_) acc = __builtin_amdgcn_mfma_f32_32x32x16_bf16(src[i_], pm[4 * (g_) + i_], acc, 0, 0, 0); } while (0)
#pragma unroll
          for (int g4 = 0; g4 < 4; ++g4) { SSM_XLD(fa, g4); __builtin_amdgcn_sched_barrier(0); SSM_XMM(fa, g4); __builtin_amdgcn_sched_barrier(0); }
#undef SSM_XLD
#undef SSM_XMM
#pragma unroll
          for (int r = 0; r < 16; ++r) XL[(32 * rb1 + crow(r, hi)) * 128 + 32 * cb1 + r32] = acc[r]; }
        bf16x8 qf[8];
#pragma unroll
        for (int ks = 0; ks < 8; ++ks) qf[ks] = *(const bf16x8*)(Tp + 256 + 16 * ks);
        __syncthreads();
        if (wid == 0) {
            for (int c0 = 0; c0 < 64; c0 += 8) {
                float xr[8], xi[8];
#pragma unroll
                for (int j = 0; j < 8; ++j) { xr[j] = XL[(c0 + j) * 128 + lane]; xi[j] = XL[(c0 + j) * 128 + 64 + lane]; }
#pragma unroll
                for (int j = 0; j < 8; ++j) {
                    *(LAS unsigned short*)(XI + (c0 + j) * 272 + lane * 2) = (unsigned short)(cvt_pk_bf16(sr, 0.f) & 0xffffu);
                    *(LAS unsigned short*)(XI + (c0 + j) * 272 + 128 + lane * 2) = (unsigned short)(cvt_pk_bf16(si, 0.f) & 0xffffu);
                    const float nr = a16r * sr - a16i * si + xr[j], ni = a16r * si + a16i * sr + xi[j];
                    sr = nr; si = ni;
                }
            }
        }
        __syncthreads();
        { f32x16 acc[2];
#pragma unroll
          for (int rb = 0; rb < 2; ++rb)
#pragma unroll
            for (int r = 0; r < 16; ++r) acc[rb][r] = 0.f;
          LAS const unsigned char* ya = UQ + r32 * 528 + 16 * hi;
          LAS const unsigned char* yx = XI + r32 * 272 + 16 * hi;
          bf16x8 fa[4];
#define SSM_YLD(dst, g_) do { _Pragma("unroll") for (int i_ = 0; i_ < 2; ++i_) _Pragma("unroll") for (int rb = 0; rb < 2; ++rb) { const int ks_ = 2 * (g_) + i_; \
              dst[2 * i_ + rb] = (ks_ < 16) ? *(LAS const bf16x8*)(ya + rb * (32 * 528) + 32 * ks_) : *(LAS const bf16x8*)(yx + rb * (32 * 272) + 32 * (ks_ - 16)); } } while (0)
#define SSM_YMM(src, g_) do { _Pragma("unroll") for (int i_ = 0; i_ < 2; ++i_) _Pragma("unroll") for (int rb = 0; rb < 2; ++rb) { const int ks_ = 2 * (g_) + i_; \
              acc[rb] = __builtin_amdgcn_mfma_f32_32x32x16_bf16(src[2 * i_ + rb], (ks_ < 16) ? tq[ks_ & 15] : qf[ks_ & 7], acc[rb], 0, 0, 0); } } while (0)
#pragma unroll
          for (int g2 = 0; g2 < 12; ++g2) { SSM_YLD(fa, g2); __builtin_amdgcn_sched_barrier(0); SSM_YMM(fa, g2); __builtin_amdgcn_sched_barrier(0); }
#undef SSM_YLD
#undef SSM_YMM
          LAS unsigned short* YS = (LAS unsigned short*)XL;
#pragma unroll
          for (int rb = 0; rb < 2; ++rb)
#pragma unroll
            for (int r = 0; r < 16; ++r) { const int c = 32 * rb + crow(r, hi);
                const float gv = gelu_tanh(acc[rb][r]);
                YS[c * 256 + 32 * wid + r32] = (unsigned short)(cvt_pk_bf16(gv, 0.f) & 0xffffu); } }
        __syncthreads();
        if (do_store) {
#pragma unroll
        for (int j = 0; j < 4; ++j) { const int id = j * 512 + tid, c = id >> 5, pos = id & 31, tau = pos >> 1, h8 = (pos & 1) * 8;
            const u32x4 v = *(LAS const u32x4*)((LAS const unsigned char*)XL + c * 512 + pos * 16);
            *(u32x4*)(QKVU + ((size_t)b * SEQ + (size_t)(64 * qi + c) * 16 + tau) * DIN + 3072 + g * HGC + h8) = v; }
        }
        __syncthreads();
    }
}

#define XB_TMO      128
#define XB_XCNT(j)  (256  + 64 * (j))
#define XB_XSUB(j)  (1280 + 64 * (j))
#define XB_XGEN(j)  (2304 + 64 * (j))
#define XB_TOP      3328
#define XB_TOPGEN   3392
#define XCD_BAR_WORDS 3456
#define XB_SPIN_CAP (1u << 18)
__device__ __forceinline__ unsigned xb_ld(unsigned* p)              { return __hip_atomic_load(p, __ATOMIC_RELAXED, __HIP_MEMORY_SCOPE_AGENT); }
__device__ __forceinline__ unsigned xb_add(unsigned* p, unsigned v) { return __hip_atomic_fetch_add(p, v, __ATOMIC_RELAXED, __HIP_MEMORY_SCOPE_AGENT); }
__device__ __forceinline__ unsigned xb_xcc_id() { return (unsigned)__builtin_amdgcn_s_getreg((3 << 11) | 20) & 0xFu; }
#define XB_SPIN(cond, bar) do { unsigned _sp = 0; while (cond) { __builtin_amdgcn_s_sleep(1); \
    if ((++_sp & 255u) == 0u) { if (xb_ld(&(bar)[XB_TMO])) break; if (_sp > XB_SPIN_CAP) { atomicAdd(&(bar)[XB_TMO], 1u); break; } } } } while (0)
struct XcdBarrier { unsigned* bar; unsigned x; volatile LAS unsigned* st; };
__device__ __forceinline__ XcdBarrier xcd_barrier_post(unsigned* bar, volatile LAS unsigned* st) {
    XcdBarrier b; b.bar = bar; b.x = xb_xcc_id(); b.st = st;
    if (threadIdx.x == 0) (void)xb_add(&bar[XB_XCNT(b.x)], 1u);
    return b;
}
__device__ __forceinline__ void xcd_barrier_complete(unsigned* bar, unsigned x, unsigned& nloc, unsigned& nx) {
    const unsigned G = gridDim.x * gridDim.y * gridDim.z;
    unsigned sum, cnt, mine, sp = 0u;
    for (;;) {
        sum = 0u; cnt = 0u; mine = 0u;
#pragma unroll
        for (unsigned j = 0; j < 16; ++j) { const unsigned c = xb_ld(&bar[XB_XCNT(j)]); sum += c; cnt += (c > 0u) ? 1u : 0u; mine = (j == x) ? c : mine; }
        if (sum == G) break;
        __builtin_amdgcn_s_sleep(1);
        if ((++sp & 255u) == 0u) { if (xb_ld(&bar[XB_TMO])) break; if (sp > XB_SPIN_CAP) { atomicAdd(&bar[XB_TMO], 1u); break; } }
    }
    nloc = mine > 0u ? mine : 1u; nx = cnt > 0u ? cnt : 1u;
}
__device__ __forceinline__ void xcd_barrier(const XcdBarrier& b) {
    asm volatile("s_waitcnt vmcnt(0)" ::: "memory");
    __syncthreads();
    if (threadIdx.x == 0) {
        unsigned* bar = b.bar;
        __builtin_amdgcn_s_waitcnt(0);
        unsigned nloc = b.st[0], nx = b.st[1];
        if (nloc == 0u) { xcd_barrier_complete(bar, b.x, nloc, nx); b.st[0] = nloc; b.st[1] = nx; }
        const unsigned old = xb_add(&bar[XB_XSUB(b.x)], 1u);
        const unsigned gen = old / nloc;
        if (old + 1u == (gen + 1u) * nloc) {
            __builtin_amdgcn_fence(__ATOMIC_RELEASE, "agent");
            asm volatile("s_waitcnt vmcnt(0)" ::: "memory");
            const unsigned og = xb_add(&bar[XB_TOP], 1u);
            const unsigned tg = og / nx;
            if (og + 1u == (tg + 1u) * nx) xb_add(&bar[XB_TOPGEN], 1u);
            else XB_SPIN(xb_ld(&bar[XB_TOPGEN]) == tg, bar);
            __builtin_amdgcn_fence(__ATOMIC_ACQUIRE, "agent");
            xb_add(&bar[XB_XGEN(b.x)], 1u);
            asm volatile("s_waitcnt vmcnt(0)" ::: "memory");
        } else {
            XB_SPIN(xb_ld(&bar[XB_XGEN(b.x)]) == gen, bar);
            __builtin_amdgcn_fence(__ATOMIC_ACQUIRE, "agent");
            asm volatile("s_waitcnt vmcnt(0)" ::: "memory");
        }
    }
    __syncthreads();
}

static __device__ const unsigned att_tab[64] = {173134591u,155831038u,138527485u,2021260023u,1886515958u,1751771893u,1617027836u,1482283764u,3368634095u,3233891822u,3099149549u,2964407276u,2829667815u,2694925542u,2560183269u,120801252u,2425443551u,2290701278u,103960541u,1345277660u,2155961303u,1210996694u,1076713173u,942429652u,808148943u,673865422u,338124237u,321281228u,304441031u,287598022u,4163069125u,4028785604u,469331391u,452029630u,434727869u,88041404u,400651447u,383349686u,71200693u,54357684u,366050223u,37517230u,20674221u,3831212u,540515239u,406229926u,271944613u,255099812u,240827295u,223523742u,206220189u,188916636u,3900365719u,3765621654u,3630877589u,3496133524u,530250639u,512947086u,495643533u,478339980u,968523655u,833781382u,699039109u,564296836u};

__global__ void __launch_bounds__(512, 2) mk_fwd(Args args) {
    extern __shared__ __attribute__((aligned(16))) unsigned char lds_raw[];
    LAS unsigned char* lds = (LAS unsigned char*)lds_raw;
    cg::grid_group grid = cg::this_grid();
    const int tid = threadIdx.x, lane = tid & 63, wave = __builtin_amdgcn_readfirstlane(tid >> 6);
    const int G = gridDim.x, bx = blockIdx.x;
    const int vcu = (G % 8 == 0) ? (bx % 8) * (G / 8) + bx / 8 : bx;
    unsigned char* ws = args.ws;
    const float* x = args.in[0];
    float* out = args.out;
    float* ss1 = (float*)(ws + WS_SS1); float* ss2 = (float*)(ws + WS_SS2); float* ss3 = (float*)(ws + WS_SS3); float* A16 = (float*)(ws + WS_A16);
    bf16_t* Wgu1 = (bf16_t*)(ws + WS_WGU1); bf16_t* Wd1 = (bf16_t*)(ws + WS_WD1); bf16_t* Win = (bf16_t*)(ws + WS_WIN); bf16_t* Wglu = (bf16_t*)(ws + WS_WGLU);
    bf16_t* Wout = (bf16_t*)(ws + WS_WOUT); bf16_t* Wgu2 = (bf16_t*)(ws + WS_WGU2); bf16_t* Wd2 = (bf16_t*)(ws + WS_WD2);
    bf16_t* TQ = (bf16_t*)(ws + WS_TQ); bf16_t* PM = (bf16_t*)(ws + WS_PM); bf16_t* XN = (bf16_t*)(ws + WS_XN); bf16_t* ACT = (bf16_t*)(ws + WS_ACT);
    bf16_t* QKVU = (bf16_t*)(ws + WS_QKVU); bf16_t* UP = (bf16_t*)(ws + WS_UP); float* KN = (float*)(ws + WS_KN);
    const int lo = args.ph_lo, hi_ph = args.ph_hi;
#define IN(k) (lo <= (k) && (k) < hi_ph)
    volatile LAS unsigned* bst = (volatile LAS unsigned*)(lds + 131072 + 64);
    if (tid < 4) bst[tid] = 0u;
    __syncthreads();
    unsigned* barw = (unsigned*)(ws + WS_BAR);
    if (args.ph_lo < 0) grid.sync();
    XcdBarrier xbar = xcd_barrier_post(barw, bst);
#define SEAM(k) do { if (IN(k) && IN((k) + 1)) xcd_barrier(xbar); } while (0)

    if (IN(0)) {
        { LAS float* scr = (LAS float*)(lds + wave * 8448);
          const int gw = vcu * 8 + wave, NGW = G * 8;
          constexpr int I_F = (DM / 64) * (DFF / 32), I_D = (DFF / 64) * (DM / 32), I_IN = (DM / 64) * (DIN / 32), I_GL = (1024 / 64) * (1024 / 32), I_O = (DM / 64) * (DM / 32);
          constexpr int NITEMS = 4 * I_F + 2 * I_D + I_IN + I_GL + I_O;
          for (int it = gw; it < (PROBE == 3 ? 2 : 1) * NITEMS; it += NGW) {
              int r = it % NITEMS;
              if (r < I_F) { tr_item(args.in[2], DM, DFF, Wgu1, nullptr, 1, scr, r, lane); continue; } r -= I_F;
              if (r < I_F) { tr_item(args.in[3], DM, DFF, Wgu1, nullptr, 2, scr, r, lane); continue; } r -= I_F;
              if (r < I_D) { tr_item(args.in[4], DFF, DM, Wd1, nullptr, 0, scr, r, lane); continue; } r -= I_D;
              if (r < I_IN) { tr_item(args.in[6], DM, DIN, Win, args.in[5], 0, scr, r, lane); continue; } r -= I_IN;
              if (r < I_GL) { tr_item(args.in[20], 1024, 1024, Wglu, nullptr, 0, scr, r, lane); continue; } r -= I_GL;
              if (r < I_O) { tr_item(args.in[22], DM, DM, Wout, nullptr, 0, scr, r, lane); continue; } r -= I_O;
              if (r < I_F) { tr_item(args.in[24], DM, DFF, Wgu2, args.in[23], 1, scr, r, lane); continue; } r -= I_F;
              if (r < I_F) { tr_item(args.in[25], DM, DFF, Wgu2, args.in[23], 2, scr, r, lane); continue; } r -= I_F;
              tr_item(args.in[26], DFF, DM, Wd2, nullptr, 0, scr, r, lane);
          }
          const float* g1 = args.in[1];
          f32x4 g1v[8];
#pragma unroll
          for (int j = 0; j < 8; ++j) g1v[j] = *((const f32x4*)g1 + lane + 64 * j);
          for (int m2 = gw; m2 < (PROBE == 8 ? 2 : 1) * MTOK; m2 += NGW) {
              const int m = m2 % MTOK;
              const f32x4* xr = (const f32x4*)(x + (size_t)m * DM) + lane;
              f32x4 v[8]; float s = 0.f;
#pragma unroll
              for (int j = 0; j < 8; ++j) { v[j] = xr[64 * j]; s += (v[j][0] * v[j][0] + v[j][1] * v[j][1]) + (v[j][2] * v[j][2] + v[j][3] * v[j][3]); }
              const float rs = rsqrtf(wave_sum(s) * (1.0f / DM) + NORM_EPS);
              u32x2* o8 = (u32x2*)(XN + (size_t)m * DM) + lane;
#pragma unroll
              for (int j = 0; j < 8; ++j) { const f32x4 gg = g1v[j]; u32x2 w; w.x = cvt_pk_bf16(v[j][0] * rs * gg[0], v[j][1] * rs * gg[1]); w.y = cvt_pk_bf16(v[j][2] * rs * gg[2], v[j][3] * rs * gg[3]); o8[64 * j] = w; }
          }
        }
        for (int i = bx * 512 + tid; i < 3 * MTOK; i += G * 512) ((float*)(ws + WS_SS1))[i] = 0.f;
        for (int i = bx * 512 + tid; i < BATCH * 16 * SEQ; i += G * 512) KN[i] = 0.f;
        __syncthreads();
        if (bx < 256) {
            const int g = bx & 63, part = bx >> 6;
            LAS float* pwr = (LAS float*)lds; LAS float* pwi = pwr + 17 * 64; LAS float* bbr = pwi + 17 * 64; LAS float* bbi = bbr + 1024; LAS float* crr = bbi + 1024; LAS float* cii = crr + 1024; LAS float* Kd = cii + 1024;
            const float* lam_re = args.in[12] + g * NST; const float* lam_im = args.in[13] + g * NST;
            const float dt = expf(args.in[14][g]);
            for (int idx = tid; idx < 17 * 64; idx += 512) { const int d = idx >> 6, p = idx & 63; const float lr = lam_re[p], li = lam_im[p];
                const float mag = expf((float)d * (lr * dt)), ang = (float)d * (li * dt); pwr[idx] = mag * cosf(ang); pwi[idx] = mag * sinf(ang); }
            for (int idx = tid; idx < 1024; idx += 512) { const int p = idx >> 4; const float lr = lam_re[p], li = lam_im[p];
                const float mag = expf(lr * dt), abr = mag * cosf(li * dt), abi = mag * sinf(li * dt), den = lr * lr + li * li;
                const float fr_ = ((abr - 1.0f) * lr + abi * li) / den, fi_ = (abi * lr - (abr - 1.0f) * li) / den;
                const float br = args.in[15][(size_t)g * 1024 + idx], bi = args.in[16][(size_t)g * 1024 + idx];
                bbr[idx] = fr_ * br - fi_ * bi; bbi[idx] = fr_ * bi + fi_ * br;
                crr[idx] = args.in[17][(size_t)g * 1024 + idx]; cii[idx] = args.in[18][(size_t)g * 1024 + idx]; }
            __syncthreads();
            {
              const int d = tid >> 5, h = (tid >> 1) & 15, hb = (tid & 1) * 8; float acc8[8];
#pragma unroll
              for (int j = 0; j < 8; ++j) acc8[j] = 0.f;
              for (int p = 0; p < 64; ++p) { const float cr = crr[h * 64 + p], ci = cii[h * 64 + p], pr = pwr[d * 64 + p], pi = pwi[d * 64 + p];
                  const float er = cr * pr - ci * pi, ei = cr * pi + ci * pr;
                  const f32x4 br0 = *(LAS const f32x4*)(bbr + p * 16 + hb), br1 = *(LAS const f32x4*)(bbr + p * 16 + hb + 4), bi0 = *(LAS const f32x4*)(bbi + p * 16 + hb), bi1 = *(LAS const f32x4*)(bbi + p * 16 + hb + 4);
#pragma unroll
                  for (int j = 0; j < 4; ++j) { acc8[j] += er * br0[j] - ei * bi0[j]; acc8[4 + j] += er * br1[j] - ei * bi1[j]; } }
#pragma unroll
              for (int j = 0; j < 8; ++j) { float a = acc8[j]; if (d == 0 && h == hb + j) a += args.in[19][g * HGC + h]; Kd[d * 256 + h * 16 + hb + j] = a; } }
            __syncthreads();
            bf16_t* TQg = TQ + (size_t)g * 256 * 384; bf16_t* PMg = PM + (size_t)g * 128 * 256;
            for (int ck = tid; ck < 64 * 48; ck += 512) { const int row = 64 * part + ck / 48, c8 = (ck % 48) * 8, tau = row >> 4, h = row & 15; float v[8];
                if (c8 < 256) { const int sg = c8 >> 4, h2 = c8 & 15;
                    if (tau >= sg) { const f32x4 k0 = *(LAS const f32x4*)(Kd + (tau - sg) * 256 + h * 16 + h2), k1 = *(LAS const f32x4*)(Kd + (tau - sg) * 256 + h * 16 + h2 + 4);
#pragma unroll
                        for (int j = 0; j < 4; ++j) { v[j] = k0[j]; v[4 + j] = k1[j]; } }
                    else {
#pragma unroll
                        for (int j = 0; j < 8; ++j) v[j] = 0.f; } }
                else { const bool im = (c8 >= 320); const int p = c8 - (im ? 320 : 256);
                    const f32x4 cr0 = *(LAS const f32x4*)(crr + h * 64 + p), cr1 = *(LAS const f32x4*)(crr + h * 64 + p + 4), ci0 = *(LAS const f32x4*)(cii + h * 64 + p), ci1 = *(LAS const f32x4*)(cii + h * 64 + p + 4);
                    const f32x4 pr0 = *(LAS const f32x4*)(pwr + (tau + 1) * 64 + p), pr1 = *(LAS const f32x4*)(pwr + (tau + 1) * 64 + p + 4), pi0 = *(LAS const f32x4*)(pwi + (tau + 1) * 64 + p), pi1 = *(LAS const f32x4*)(pwi + (tau + 1) * 64 + p + 4);
#pragma unroll
                    for (int j = 0; j < 4; ++j) { v[j] = im ? -(cr0[j] * pi0[j] + ci0[j] * pr0[j]) : (cr0[j] * pr0[j] - ci0[j] * pi0[j]);
                                                  v[4 + j] = im ? -(cr1[j] * pi1[j] + ci1[j] * pr1[j]) : (cr1[j] * pr1[j] - ci1[j] * pi1[j]); } }
                u32x4 w; w.x = cvt_pk_bf16(v[0], v[1]); w.y = cvt_pk_bf16(v[2], v[3]); w.z = cvt_pk_bf16(v[4], v[5]); w.w = cvt_pk_bf16(v[6], v[7]);
                *(u32x4*)(TQg + (size_t)row * 384 + c8) = w; }
            for (int ck = tid; ck < 32 * 32; ck += 512) { const int row = 32 * part + (ck >> 5), c8 = (ck & 31) * 8, sg = c8 >> 4, h2 = c8 & 15, p = row & 63;
                const float pr = pwr[(15 - sg) * 64 + p], pi = pwi[(15 - sg) * 64 + p];
                const f32x4 br0 = *(LAS const f32x4*)(bbr + p * 16 + h2), br1 = *(LAS const f32x4*)(bbr + p * 16 + h2 + 4), bi0 = *(LAS const f32x4*)(bbi + p * 16 + h2), bi1 = *(LAS const f32x4*)(bbi + p * 16 + h2 + 4);
                float v[8];
#pragma unroll
                for (int j = 0; j < 4; ++j) { v[j] = (row < 64) ? (pr * br0[j] - pi * bi0[j]) : (pr * bi0[j] + pi * br0[j]); v[4 + j] = (row < 64) ? (pr * br1[j] - pi * bi1[j]) : (pr * bi1[j] + pi * br1[j]); }
                u32x4 w; w.x = cvt_pk_bf16(v[0], v[1]); w.y = cvt_pk_bf16(v[2], v[3]); w.z = cvt_pk_bf16(v[4], v[5]); w.w = cvt_pk_bf16(v[6], v[7]);
                *(u32x4*)(PMg + (size_t)row * 256 + c8) = w; }
            if (part == 0 && tid < 64) { A16[(g * NST + tid) * 2] = pwr[16 * 64 + tid]; A16[(g * NST + tid) * 2 + 1] = pwi[16 * 64 + tid]; }
        }
        __syncthreads();
    }
    SEAM(0);
#if PROBE == 4
    for (int i = 0; i < 20; ++i) grid.sync();
#endif
    for (int rep1 = 0; rep1 < (PROBE == 5 ? 2 : 1); ++rep1)
    if (IN(1)) {
        pg8::Gemm g{XN, Wgu1, MTOK, 2 * DFF, DM, DM, DM}; pg8::StaticOrder S; S.init(MTOK, 2 * DFF, G, bx);
        pg8::EpiSwiGLU E{ACT, DFF, nullptr};
        pg8::gemm_phase<pg8::EpiSwiGLU, pg8::StaticOrder>(lds, g, S, E);
    }
    SEAM(1);
    if (IN(2)) {
        pg8::Gemm g{ACT, Wd1, MTOK, DM, DFF, DFF, DFF}; pg8::StaticOrder S; S.init(MTOK, DM, G, bx);
        pg8::EpiResid E{x, out, XN, ss1, 0.5f, (LAS float*)(lds + 131072 + 4096)};
        pg8::gemm_phase<pg8::EpiResid, pg8::StaticOrder>(lds, g, S, E);
    }
    SEAM(2);
    for (int rep3 = 0; rep3 < (PROBE == 7 ? 2 : 1); ++rep3)
    if (IN(3)) {
        pg8::Gemm g{XN, Win, MTOK, DIN, DM, DM, DM}; pg8::StaticOrder S; S.init(MTOK, DIN, G, bx);
        pg8::EpiWin E{QKVU, UP, ss1, KN, (LAS float*)(lds + 131072 + 8192)};
        pg8::gemm_phase<pg8::EpiWin, pg8::StaticOrder>(lds, g, S, E);
    }
    SEAM(3);
    if (IN(4)) {
        float lam;
        { const float a = wave_sum(args.in[7][lane] * args.in[8][lane]), c = wave_sum(args.in[9][lane] * args.in[10][lane]); lam = expf(a) - expf(c) + LAMBDA_INIT; }
        for (int cu = vcu; cu < 256; cu += G) {
            const int b = cu >> 6; const unsigned e = att_tab[cu & 63];
            for (int ui = 0; ui < 4; ++ui) {
                const unsigned u8 = (e >> (8 * ui)) & 255u;
                attn_unit(b, (int)(u8 & 7u), (int)(u8 >> 3), QKVU, QKVU, DIN, KN, lds, lam, args.in[11]);
            }
        }
        if (bx < 256) {
            ssm_unit(bx >> 6, bx & 63, UP, TQ, PM, A16, QKVU, lds, true);
#if PROBE == 2
            ssm_unit(bx >> 6, bx & 63, UP, TQ, PM, A16, QKVU, lds, true);
#endif
#if PROBE == 9
            ssm_unit(bx >> 6, bx & 63, UP, TQ, PM, A16, QKVU, lds, false);
#endif
        }
    }
    SEAM(4);
    for (int rep5 = 0; rep5 < (PROBE == 6 ? 2 : 1); ++rep5)
    if (IN(5)) {
        pg8::Gemm g{QKVU + 3072, Wglu, MTOK, 1024, 1024, DIN, 1024}; pg8::StaticOrder S; S.init(MTOK, 1024, G, bx);
        pg8::EpiGlu E{QKVU, args.in[21]};
        pg8::gemm_phase<pg8::EpiGlu, pg8::StaticOrder>(lds, g, S, E);
    }
    SEAM(5);
    if (IN(6)) {
        pg8::Gemm g{QKVU, Wout, MTOK, DM, DM, DIN, DM}; pg8::StaticOrder S; S.init(MTOK, DM, G, bx);
        pg8::EpiResid E{out, out, XN, ss2, 1.0f, (LAS float*)(lds + 131072 + 4096)};
        pg8::gemm_phase<pg8::EpiResid, pg8::StaticOrder>(lds, g, S, E);
    }
    SEAM(6);
    if (IN(7)) {
        pg8::Gemm g{XN, Wgu2, MTOK, 2 * DFF, DM, DM, DM}; pg8::StaticOrder S; S.init(MTOK, 2 * DFF, G, bx);
        pg8::EpiSwiGLU E{ACT, DFF, ss2};
        pg8::gemm_phase<pg8::EpiSwiGLU, pg8::StaticOrder>(lds, g, S, E);
    }
    SEAM(7);
    const bool fused_tail = (G == 256);
    if (IN(8)) {
        pg8::Gemm g{ACT, Wd2, MTOK, DM, DFF, DFF, DFF};
        if (fused_tail) {
            pg8::FusedOrder S{bx};
            pg8::EpiResidNorm E{out, out, ss3, (unsigned*)(ws + WS_PCNT), args.in[27], 0.5f, (LAS float*)(lds + 131072 + 4096)};
            pg8::gemm_phase<pg8::EpiResidNorm, pg8::FusedOrder>(lds, g, S, E);
        } else {
            pg8::StaticOrder S; S.init(MTOK, DM, G, bx);
            pg8::EpiResid E{out, out, nullptr, ss3, 0.5f, (LAS float*)(lds + 131072 + 4096)};
            pg8::gemm_phase<pg8::EpiResid, pg8::StaticOrder>(lds, g, S, E);
        }
    }
    if (!fused_tail) SEAM(8);
    if (IN(9) && !fused_tail) {
        const float* gf = args.in[27];
        const int gw = vcu * 8 + wave, NGW = G * 8;
        f32x4 ggv[8];
#pragma unroll
        for (int j = 0; j < 8; ++j) ggv[j] = *((const f32x4*)gf + lane + 64 * j);
        for (int m = gw; m < MTOK; m += NGW) {
            const float rs = rsqrtf(ss3[m] * (1.0f / DM) + NORM_EPS);
            f32x4* xr = (f32x4*)(out + (size_t)m * DM) + lane;
            f32x4 v[8];
#pragma unroll
            for (int j = 0; j < 8; ++j) v[j] = xr[64 * j];
#pragma unroll
            for (int j = 0; j < 8; ++j) xr[64 * j] = v[j] * rs * ggv[j];
        }
    }
#undef IN
#undef SEAM
}

#ifndef MK_N_LAUNCHES
#define MK_N_LAUNCHES 1
#endif
constexpr int N_PHASES = 10;

extern "C" void kernel_launch(void* const* d_in, const int* in_sizes, int n_in, void* d_out, int out_size, void* d_ws, size_t ws_size, hipStream_t stream) {
    static int grid = 0;
    if (grid == 0) {
        if (n_in != 28 || ws_size < WS_END) { fprintf(stderr, "kernel_launch: unexpected inputs (n_in %d, ws %zu)\n", n_in, ws_size); grid = -1; return; }
        int dev = 0, cus = 0, per_cu = 0;
        (void)hipGetDevice(&dev);
        (void)hipDeviceGetAttribute(&cus, hipDeviceAttributeMultiprocessorCount, dev);
        (void)hipFuncSetAttribute((const void*)mk_fwd, hipFuncAttributeMaxDynamicSharedMemorySize, LDS_BYTES);
        (void)hipOccupancyMaxActiveBlocksPerMultiprocessor(&per_cu, (const void*)mk_fwd, 512, LDS_BYTES);
        if (per_cu < 1) { fprintf(stderr, "kernel_launch: occupancy query reports %d blocks per CU\n", per_cu); per_cu = 1; }
        (void)hipGetLastError();
        grid = cus;
    }
    if (grid < 0) return;
    if (hipMemsetAsync((char*)d_ws + WS_BAR, 0, 16384 + 64 * 256, stream) != hipSuccess) { fprintf(stderr, "kernel_launch: memset of the barrier words failed\n"); return; }
    Args a{};
    for (int i = 0; i < 28; ++i) a.in[i] = (const float*)d_in[i];
    a.out = (float*)d_out; a.ws = (unsigned char*)d_ws;
#if MK_N_LAUNCHES == 1
    a.ph_lo = 0; a.ph_hi = N_PHASES;
    void* kargs[] = {&a};
    hipError_t e = hipLaunchCooperativeKernel((const void*)mk_fwd, dim3(grid), dim3(512), kargs, LDS_BYTES, stream);
    if (e != hipSuccess) fprintf(stderr, "cooperative launch failed: %s (grid %d)\n", hipGetErrorString(e), grid);
#else
    for (int p = 0; p < N_PHASES; ++p) { a.ph_lo = p; a.ph_hi = p + 1; hipLaunchKernelGGL(mk_fwd, dim3(grid), dim3(512), LDS_BYTES, stream, a); }
#endif
}
```

```cpp
#include <hip/hip_runtime.h>
#include <hip/hip_cooperative_groups.h>
#include <cstdio>
#include <cstdint>
#include <cmath>
namespace cg = cooperative_groups;
#ifndef PROBE
#define PROBE 0
#endif

#define LAS __attribute__((address_space(3)))
typedef unsigned short bf16_t;
typedef short bf16x8 __attribute__((ext_vector_type(8)));
typedef short s16x4 __attribute__((ext_vector_type(4)));
typedef float f32x2 __attribute__((ext_vector_type(2)));
typedef float f32x4 __attribute__((ext_vector_type(4)));
typedef float f32x16 __attribute__((ext_vector_type(16)));
typedef unsigned u32x2 __attribute__((ext_vector_type(2)));
typedef unsigned u32x4 __attribute__((ext_vector_type(4)));

constexpr int BATCH = 4, SEQ = 4096, DM = 2048, MTOK = BATCH * SEQ, DFF = 5632, DIN = 4096;
constexpr int NGRP = 64, NST = 64, HGC = 16;
constexpr float NORM_EPS = 1e-6f, SUBLN_EPS = 1e-5f;
constexpr float LOG2E = 1.4426950408889634f;
constexpr float QSCALE = 0.125f * LOG2E;
constexpr float LAMBDA_INIT = 0.2f;

__device__ __forceinline__ unsigned cvt_pk_bf16(float lo, float hi) { unsigned r; asm volatile("v_cvt_pk_bf16_f32 %0, %1, %2" : "=v"(r) : "v"(lo), "v"(hi)); return r; }
typedef __bf16 bf16x2_t __attribute__((ext_vector_type(2)));
__device__ __forceinline__ unsigned cvt_pk_bf16_b(float lo, float hi) { const f32x2 v = {lo, hi}; const bf16x2_t b = __builtin_convertvector(v, bf16x2_t); return __builtin_bit_cast(unsigned, b); }
__device__ __forceinline__ float bf16_to_f32(unsigned short v) { return __uint_as_float(((unsigned)v) << 16); }
__device__ __forceinline__ float wave_sum(float v) {
#pragma unroll
    for (int o = 1; o < 64; o <<= 1) v += __shfl_xor(v, o);
    return v;
}

namespace pg8 {
constexpr int BM = 256, BK = 64, HALF = 128, HTB = HALF * BK * 2, STAGE_BYTES = 8 * HTB, NXCD = 8, WGM = 8;
__host__ __device__ __forceinline__ int lds_byte(int r, int c) { const int st = (r >> 4) * 2 + (c >> 5), rr = r & 15, cc = c & 31, ob = rr * 64 + cc * 2; return st * 1024 + (ob ^ (((ob >> 9) & 1) << 5)); }
__host__ __device__ __forceinline__ void stage_rc(int b, int& R, int& C) { const int st = b / 1024, sb = b % 1024, swz = sb ^ (((sb >> 9) & 1) << 5); R = (st >> 1) * 16 + swz / 64; C = (st & 1) * 32 + (swz % 64) / 2; }
__host__ __device__ __forceinline__ int perm32(int rho) { const int n = rho >> 4, i = rho & 15; return 8 * (i >> 2) + 4 * n + (i & 3); }

struct Unit { int pm, pn; };
struct Gemm { const bf16_t* A; const bf16_t* Bt; int M, N, K, lda, ldb; };

struct StaticOrder {
    int nM, nN, nwg, G, c;
    __host__ __device__ void init(int M, int N, int G_, int c_) { nM = M / BM; nN = N / BM; nwg = nM * nN; G = G_; c = c_; }
    __host__ __device__ bool next(int i, Unit& u) const {
        const long L = (long)i * G + c; if (L >= nwg) return false;
        int wgid = (int)L; { const int q = nwg / NXCD, r = nwg % NXCD, xcd = wgid % NXCD, off = wgid / NXCD; wgid = (xcd < r ? xcd * (q + 1) : r * (q + 1) + (xcd - r) * q) + off; }
        const int nig = WGM * nN, gid = wgid / nig, fm = gid * WGM, gsz = (nM - fm) < WGM ? (nM - fm) : WGM;
        u.pm = fm + ((wgid % nig) % gsz); u.pn = (wgid % nig) / gsz; return true;
    }
};


struct EpiSwiGLU {
    static constexpr bool PERM = true;
    bf16_t* O; int ldc; const float* ss;
    __device__ __forceinline__ void operator()(const f32x4 (&acc)[2][2][4][2], const Unit& u, int wr, int wc, int fr, int fq) const {
        const int row0 = u.pm * BM + wr * 64 + fr, col0 = u.pn * HALF + wc * 32 + 8 * fq;
        float rsv[2][4];
#pragma unroll
        for (int ai = 0; ai < 2; ++ai)
#pragma unroll
            for (int m = 0; m < 4; ++m) rsv[ai][m] = ss ? ss[row0 + ai * HALF + m * 16] : 0.f;
#pragma unroll
        for (int ai = 0; ai < 2; ++ai)
#pragma unroll
            for (int m = 0; m < 4; ++m) {
                const int row = row0 + ai * HALF + m * 16;
                const float rs = ss ? rsqrtf(rsv[ai][m] * (1.0f / DM) + NORM_EPS) : 1.0f;
                float o[8];
#pragma unroll
                for (int n = 0; n < 2; ++n)
#pragma unroll
                    for (int j = 0; j < 4; ++j) { const float gt = acc[ai][0][m][n][j] * rs, up = acc[ai][1][m][n][j] * rs;
                        o[n * 4 + j] = gt * __builtin_amdgcn_rcpf(1.0f + __expf(-gt)) * up; }
                u32x4 w; w.x = cvt_pk_bf16(o[0], o[1]); w.y = cvt_pk_bf16(o[2], o[3]); w.z = cvt_pk_bf16(o[4], o[5]); w.w = cvt_pk_bf16(o[6], o[7]);
                *(u32x4*)(O + (size_t)row * ldc + col0) = w;
            }
    }
};
struct EpiResid {
    static constexpr bool PERM = true;
    const float* base; float* out; bf16_t* xb; float* ss; float alpha; LAS float* part;
    __device__ __forceinline__ void operator()(const f32x4 (&acc)[2][2][4][2], const Unit& u, int wr, int wc, int fr, int fq) const {
        const int row0 = u.pm * BM + wr * 64 + fr, col0 = u.pn * BM + wc * 32 + 8 * fq;
#pragma unroll
        for (int ai = 0; ai < 2; ++ai) {
#pragma unroll
          for (int mh = 0; mh < 2; ++mh) {
          f32x4 bb[2][2][2];
#pragma unroll
          for (int m2 = 0; m2 < 2; ++m2)
#pragma unroll
            for (int bj = 0; bj < 2; ++bj) { const size_t off = (size_t)(row0 + ai * HALF + (2 * mh + m2) * 16) * DM + col0 + bj * HALF;
                bb[m2][bj][0] = *(const f32x4*)(base + off); bb[m2][bj][1] = *(const f32x4*)(base + off + 4); }
#pragma unroll
            for (int m2 = 0; m2 < 2; ++m2) { const int m = 2 * mh + m2;
                const int row = row0 + ai * HALF + m * 16; float sq = 0.f;
#pragma unroll
                for (int bj = 0; bj < 2; ++bj) {
                    const size_t off = (size_t)row * DM + col0 + bj * HALF;
                    const f32x4 b0 = bb[m2][bj][0], b1 = bb[m2][bj][1];
                    const f32x4 v0 = b0 + acc[ai][bj][m][0] * alpha, v1 = b1 + acc[ai][bj][m][1] * alpha;
                    *(f32x4*)(out + off) = v0; *(f32x4*)(out + off + 4) = v1;
                    sq += (v0[0] * v0[0] + v0[1] * v0[1]) + (v0[2] * v0[2] + v0[3] * v0[3]) + (v1[0] * v1[0] + v1[1] * v1[1]) + (v1[2] * v1[2] + v1[3] * v1[3]);
                    if (xb) { u32x4 w; w.x = cvt_pk_bf16(v0[0], v0[1]); w.y = cvt_pk_bf16(v0[2], v0[3]); w.z = cvt_pk_bf16(v1[0], v1[1]); w.w = cvt_pk_bf16(v1[2], v1[3]); *(u32x4*)(xb + off) = w; }
                }
                sq += __shfl_xor(sq, 16); sq += __shfl_xor(sq, 32);
                if (fq == 0) part[(row - u.pm * BM) * 4 + wc] = sq;
            }
          }
        }
        asm volatile("s_waitcnt lgkmcnt(0)" ::: "memory"); __builtin_amdgcn_s_barrier();
        { const int t_ = (wr * 4 + wc) * 64 + fq * 16 + fr;
          if (t_ < 256) { const f32x4 p = *(LAS const f32x4*)(part + t_ * 4); atomicAdd(ss + u.pm * BM + t_, (p[0] + p[1]) + (p[2] + p[3])); } }
    }
};
struct EpiWin {
    static constexpr bool PERM = true;
    bf16_t* QKVU; bf16_t* UP; const float* ss; float* knorm2; LAS float* kpart;
    __device__ __forceinline__ void operator()(const f32x4 (&acc)[2][2][4][2], const Unit& u, int wr, int wc, int fr, int fq) const {
        const int row0 = u.pm * BM + wr * 64 + fr, col0 = u.pn * BM + wc * 32 + 8 * fq;
        const float cs = (u.pn < 4) ? QSCALE : 1.0f;
        float rsv[2][4];
#pragma unroll
        for (int ai = 0; ai < 2; ++ai)
#pragma unroll
            for (int m = 0; m < 4; ++m) rsv[ai][m] = ss[row0 + ai * HALF + m * 16];
#pragma unroll
        for (int ai = 0; ai < 2; ++ai)
#pragma unroll
            for (int m = 0; m < 4; ++m) {
                const int row = row0 + ai * HALF + m * 16;
                const float rs = rsqrtf(rsv[ai][m] * (1.0f / DM) + NORM_EPS) * cs;
#pragma unroll
                for (int bj = 0; bj < 2; ++bj) {
                    const f32x4 v0 = acc[ai][bj][m][0] * rs, v1 = acc[ai][bj][m][1] * rs;
                    u32x4 w; w.x = cvt_pk_bf16(v0[0], v0[1]); w.y = cvt_pk_bf16(v0[2], v0[3]); w.z = cvt_pk_bf16(v1[0], v1[1]); w.w = cvt_pk_bf16(v1[2], v1[3]);
                    const int col = col0 + bj * HALF;
                    if (u.pn >= 4 && u.pn < 8) {
                        float sq = (v0[0] * v0[0] + v0[1] * v0[1]) + (v0[2] * v0[2] + v0[3] * v0[3]) + (v1[0] * v1[0] + v1[1] * v1[1]) + (v1[2] * v1[2] + v1[3] * v1[3]);
                        sq += __shfl_xor(sq, 16); sq += __shfl_xor(sq, 32);
                        if (fq == 0) kpart[((row - u.pm * BM) * 4 + 2 * bj + (wc >> 1)) * 2 + (wc & 1)] = sq;
                    }
                    if (u.pn < 12) *(u32x4*)(QKVU + (size_t)row * DIN + col) = w;
                    else { const int cu = col - 3072, g = cu >> 4, ch = cu & 15, b = row >> 12, t = row & 4095;
                           *(u32x4*)(UP + ((size_t)(b * NGRP + g) * SEQ + t) * HGC + ch) = w; }
                }
            }
        if (u.pn >= 4 && u.pn < 8) {
            asm volatile("s_waitcnt lgkmcnt(0)" ::: "memory"); __builtin_amdgcn_s_barrier();
            const int t_ = (wr * 4 + wc) * 64 + fq * 16 + fr, rowb = u.pm * BM;
#pragma unroll
            for (int i = 0; i < 2; ++i) { const int idx = t_ + 512 * i, hcl = idx >> 8, rl = idx & 255;
                const f32x2 p = *(LAS const f32x2*)(kpart + (rl * 4 + hcl) * 2);
                atomicAdd(knorm2 + (size_t)(((rowb + rl) >> 12) * 16 + 4 * (u.pn - 4) + hcl) * SEQ + ((rowb + rl) & 4095), p[0] + p[1]); }
        }
    }
};
struct EpiGlu {
    static constexpr bool PERM = true;
    bf16_t* QKVU; const float* bias;
    __device__ __forceinline__ void operator()(const f32x4 (&acc)[2][2][4][2], const Unit& u, int wr, int wc, int fr, int fq) const {
        const int row0 = u.pm * BM + wr * 64 + fr, col0 = u.pn * BM + wc * 32 + 8 * fq;
        f32x4 bv[2][2];
#pragma unroll
        for (int bj = 0; bj < 2; ++bj) { bv[bj][0] = *(const f32x4*)(bias + col0 + bj * HALF); bv[bj][1] = *(const f32x4*)(bias + col0 + bj * HALF + 4); }
#pragma unroll
        for (int ai = 0; ai < 2; ++ai) {
          u32x4 gwv[4][2];
#pragma unroll
            for (int m = 0; m < 4; ++m)
#pragma unroll
                for (int bj = 0; bj < 2; ++bj) gwv[m][bj] = *(const u32x4*)(QKVU + (size_t)(row0 + ai * HALF + m * 16) * DIN + 3072 + col0 + bj * HALF);
#pragma unroll
            for (int m = 0; m < 4; ++m) {
                const int row = row0 + ai * HALF + m * 16;
#pragma unroll
                for (int bj = 0; bj < 2; ++bj) {
                    const int col = col0 + bj * HALF;
                    const u32x4 gw = gwv[m][bj];
                    const f32x4 b0 = bv[bj][0], b1 = bv[bj][1];
                    float o[8];
#pragma unroll
                    for (int j = 0; j < 4; ++j) {
                        const unsigned gword0 = gw[j >> 1], gword1 = gw[2 + (j >> 1)];
                        const float g0 = (j & 1) ? __uint_as_float(gword0 & 0xffff0000u) : __uint_as_float(gword0 << 16);
                        const float g1 = (j & 1) ? __uint_as_float(gword1 & 0xffff0000u) : __uint_as_float(gword1 << 16);
                        const float z0 = acc[ai][bj][m][0][j] + b0[j], z1 = acc[ai][bj][m][1][j] + b1[j];
                        o[j] = g0 * __builtin_amdgcn_rcpf(1.0f + __expf(-z0)); o[4 + j] = g1 * __builtin_amdgcn_rcpf(1.0f + __expf(-z1));
                    }
                    u32x4 w; w.x = cvt_pk_bf16(o[0], o[1]); w.y = cvt_pk_bf16(o[2], o[3]); w.z = cvt_pk_bf16(o[4], o[5]); w.w = cvt_pk_bf16(o[6], o[7]);
                    *(u32x4*)(QKVU + (size_t)row * DIN + 1024 + col) = w;
                }
            }
        }
    }
};

struct EpiResidNorm {
    static constexpr bool PERM = true;
    const float* base; float* out; float* ss; unsigned* cnt; const float* gain; float alpha; LAS float* part;
    __device__ __forceinline__ void operator()(f32x4 (&acc)[2][2][4][2], const Unit& u, int wr, int wc, int fr, int fq) const {
        const int row0 = u.pm * BM + wr * 64 + fr, col0 = u.pn * BM + wc * 32 + 8 * fq;
#pragma unroll
        for (int ai = 0; ai < 2; ++ai) {
#pragma unroll
          for (int mh = 0; mh < 2; ++mh) {
          f32x4 bb[2][2][2];
#pragma unroll
          for (int m2 = 0; m2 < 2; ++m2)
#pragma unroll
            for (int bj = 0; bj < 2; ++bj) { const size_t off = (size_t)(row0 + ai * HALF + (2 * mh + m2) * 16) * DM + col0 + bj * HALF;
                bb[m2][bj][0] = *(const f32x4*)(base + off); bb[m2][bj][1] = *(const f32x4*)(base + off + 4); }
#pragma unroll
            for (int m2 = 0; m2 < 2; ++m2) { const int m = 2 * mh + m2;
                const int row = row0 + ai * HALF + m * 16; float sq = 0.f;
#pragma unroll
                for (int bj = 0; bj < 2; ++bj) {
                    const f32x4 v0 = bb[m2][bj][0] + acc[ai][bj][m][0] * alpha, v1 = bb[m2][bj][1] + acc[ai][bj][m][1] * alpha;
                    acc[ai][bj][m][0] = v0; acc[ai][bj][m][1] = v1;
                    sq += (v0[0] * v0[0] + v0[1] * v0[1]) + (v0[2] * v0[2] + v0[3] * v0[3]) + (v1[0] * v1[0] + v1[1] * v1[1]) + (v1[2] * v1[2] + v1[3] * v1[3]);
                }
                sq += __shfl_xor(sq, 16); sq += __shfl_xor(sq, 32);
                if (fq == 0) part[(row - u.pm * BM) * 4 + wc] = sq;
            }
          }
        }
        f32x4 gv[2][2];
#pragma unroll
        for (int bj = 0; bj < 2; ++bj) { gv[bj][0] = *(const f32x4*)(gain + col0 + bj * HALF); gv[bj][1] = *(const f32x4*)(gain + col0 + bj * HALF + 4); }
        asm volatile("s_waitcnt lgkmcnt(0)" ::: "memory"); __builtin_amdgcn_s_barrier();
        { const int t_ = (wr * 4 + wc) * 64 + fq * 16 + fr;
          if (t_ < 256) { const f32x4 p = *(LAS const f32x4*)(part + t_ * 4); atomicAdd(ss + u.pm * BM + t_, (p[0] + p[1]) + (p[2] + p[3])); } }
        asm volatile("s_waitcnt vmcnt(0)" ::: "memory");
        __builtin_amdgcn_s_barrier();
        if (wr == 0 && wc == 0) {
            unsigned* c = cnt + 64 * u.pm;
            __builtin_amdgcn_fence(__ATOMIC_RELEASE, "agent");
            asm volatile("s_waitcnt vmcnt(0)" ::: "memory");
            if (fr == 0 && fq == 0) (void)__hip_atomic_fetch_add(c, 1u, __ATOMIC_RELAXED, __HIP_MEMORY_SCOPE_AGENT);
            unsigned sp = 0;
            while (__hip_atomic_load(c, __ATOMIC_RELAXED, __HIP_MEMORY_SCOPE_AGENT) < 8u) { __builtin_amdgcn_s_sleep(8); if (++sp > (1u << 21)) break; }
            __builtin_amdgcn_fence(__ATOMIC_ACQUIRE, "agent");
            asm volatile("s_waitcnt vmcnt(0)" ::: "memory");
        }
        __builtin_amdgcn_s_barrier();
        float rsv[2][4];
#pragma unroll
        for (int ai = 0; ai < 2; ++ai)
#pragma unroll
            for (int m = 0; m < 4; ++m) rsv[ai][m] = __hip_atomic_load(ss + row0 + ai * HALF + m * 16, __ATOMIC_RELAXED, __HIP_MEMORY_SCOPE_AGENT);
#pragma unroll
        for (int ai = 0; ai < 2; ++ai)
#pragma unroll
            for (int m = 0; m < 4; ++m) { const float rs = rsqrtf(rsv[ai][m] * (1.0f / DM) + NORM_EPS);
#pragma unroll
                for (int bj = 0; bj < 2; ++bj) { const size_t off = (size_t)(row0 + ai * HALF + m * 16) * DM + col0 + bj * HALF;
                    *(f32x4*)(out + off) = acc[ai][bj][m][0] * rs * gv[bj][0]; *(f32x4*)(out + off + 4) = acc[ai][bj][m][1] * rs * gv[bj][1]; } }
    }
};
struct FusedOrder {
    int c;
    __host__ __device__ bool next(int i, Unit& u) const { if (i >= 2) return false; u.pm = 32 * i + 4 * (c & 7) + (c >> 6); u.pn = (c >> 3) & 7; return true; }
};

template <class Epi, class Sched, bool ALIGN_EPI = true, bool SP2 = true>
__device__ __forceinline__ void gemm_phase(LAS unsigned char* lds, const Gemm g, const Sched& S, const Epi& E) {
    int tid = threadIdx.x; asm volatile("" : "+v"(tid));
    const int wid = __builtin_amdgcn_readfirstlane(tid >> 6), lane = tid & 63, wr = wid >> 2, wc = wid & 3, fr = lane & 15, fq = lane >> 4;
    const int K = g.K, nt = K / BK;
    unsigned voffA[2], voffB[2];
#pragma unroll
    for (int i = 0; i < 2; ++i) { int R, C; stage_rc(tid * 16 + i * 8192, R, C); const int Rb = Epi::PERM ? ((R & ~31) + perm32(R & 31)) : R;
        voffA[i] = (unsigned)(R * g.lda + C) * 2u; voffB[i] = (unsigned)(Rb * g.ldb + C) * 2u; }
    const size_t kstep = (size_t)(BK * 2);
    const size_t hA = (size_t)HALF * g.lda * 2, hB = (size_t)HALF * g.ldb * 2;
    const size_t tA = 2 * hA, tB = 2 * hB;
    const unsigned ldsw = (unsigned)wid * 1024u;
    const int aoff = lds_byte(wr * 64 + fr, fq * 8), boff = lds_byte(wc * 32 + fr, fq * 8);
#define PG8_SA(b, h) (((b) * 2 + (h)) * HTB)
#define PG8_SB(b, h) ((4 + (b) * 2 + (h)) * HTB)
#define PG8_STAGE(bufoff, gbase, voff) do { _Pragma("unroll") for (int _i = 0; _i < 2; ++_i) \
        __builtin_amdgcn_global_load_lds((const unsigned*)((const char*)(gbase) + (voff)[_i]), (LAS unsigned*)(lds + (bufoff) + ldsw + _i * 8192), 16, 0, 0); } while (0)
#define PG8_LDA(dst, b, h) do { _Pragma("unroll") for (int m = 0; m < 4; ++m) _Pragma("unroll") for (int k = 0; k < 2; ++k) dst[m][k] = *(const LAS bf16x8*)(lds + PG8_SA(b, h) + aoff + m * 2048 + k * 1024); } while (0)
#define PG8_LDB(dst, b, h) do { _Pragma("unroll") for (int n = 0; n < 2; ++n) _Pragma("unroll") for (int k = 0; k < 2; ++k) dst[n][k] = *(const LAS bf16x8*)(lds + PG8_SB(b, h) + boff + n * 2048 + k * 1024); } while (0)
#define PG8_MMA(ai, bj, At, Bt) do { __builtin_amdgcn_s_setprio(1); _Pragma("unroll") for (int m = 0; m < 4; ++m) _Pragma("unroll") for (int n = 0; n < 2; ++n) _Pragma("unroll") for (int k = 0; k < 2; ++k) \
        acc[ai][bj][m][n] = __builtin_amdgcn_mfma_f32_16x16x32_bf16(Bt[n][k], At[m][k], acc[ai][bj][m][n], 0, 0, 0); __builtin_amdgcn_s_setprio(0); } while (0)
#define PG8_WAIT_V(n) asm volatile("s_waitcnt vmcnt(" #n ")" ::: "memory")
#define PG8_WAIT_L(n) asm volatile("s_waitcnt lgkmcnt(" #n ")" ::: "memory")
#define PG8_BAR __builtin_amdgcn_s_barrier()
#define PG8_SCHED __builtin_amdgcn_sched_barrier(0)
    Unit cur, nxt; int ui = 0;
    if (!S.next(0, cur)) return;
    f32x4 acc[2][2][4][2];
#pragma unroll
    for (int a = 0; a < 2; ++a)
#pragma unroll
        for (int b = 0; b < 2; ++b)
#pragma unroll
            for (int m = 0; m < 4; ++m)
#pragma unroll
                for (int n = 0; n < 2; ++n) acc[a][b][m][n] = (f32x4){0.f, 0.f, 0.f, 0.f};
    bf16x8 At[4][2], B0[2][2], B1[2][2];
    const char* cA = (const char*)g.A + (size_t)cur.pm * tA; const char* cB = (const char*)g.Bt + (size_t)cur.pn * tB;
    if constexpr (SP2) {
        PG8_STAGE(PG8_SB(0, 0), cB, voffB); PG8_STAGE(PG8_SB(0, 1), cB + hB, voffB); PG8_STAGE(PG8_SA(0, 0), cA, voffA); PG8_STAGE(PG8_SA(0, 1), cA + hA, voffA);
        if (wr == 1) PG8_BAR;
        PG8_WAIT_V(2); PG8_BAR;
        PG8_STAGE(PG8_SB(1, 0), cB + kstep, voffB); PG8_STAGE(PG8_SA(1, 0), cA + kstep, voffA); PG8_STAGE(PG8_SB(1, 1), cB + hB + kstep, voffB);
        PG8_WAIT_V(6); PG8_BAR;
    } else {
        PG8_STAGE(PG8_SB(0, 0), cB, voffB); PG8_STAGE(PG8_SA(0, 0), cA, voffA); PG8_STAGE(PG8_SB(0, 1), cB + hB, voffB); PG8_STAGE(PG8_SA(0, 1), cA + hA, voffA);
        if (wr == 1) PG8_BAR;
        PG8_WAIT_V(4); PG8_BAR;
        PG8_STAGE(PG8_SB(1, 0), cB + kstep, voffB); PG8_STAGE(PG8_SA(1, 0), cA + kstep, voffA); PG8_STAGE(PG8_SB(1, 1), cB + hB + kstep, voffB);
        PG8_WAIT_V(6); PG8_BAR;
    }
    for (;;) {
        const bool has_next = S.next(ui + 1, nxt);
        const char* nA = has_next ? (const char*)g.A + (size_t)nxt.pm * tA : cA; const char* nB = has_next ? (const char*)g.Bt + (size_t)nxt.pn * tB : cB;
        for (int t = 0; t < nt; t += 2) {
            const bool last = (t == nt - 2);
            const char* a1 = cA + (size_t)(t + 1) * kstep;
            const char* a2 = last ? nA : cA + (size_t)(t + 2) * kstep; const char* b2 = last ? nB : cB + (size_t)(t + 2) * kstep;
            const char* a3 = a2 + kstep; const char* b3 = b2 + kstep;
            if constexpr (SP2) {
            PG8_LDB(B0, 0, 0); PG8_LDB(B1, 0, 1); PG8_SCHED; PG8_LDA(At, 0, 0); PG8_STAGE(PG8_SA(1, 1), a1 + hA, voffA);
            PG8_WAIT_V(8); PG8_WAIT_L(0); PG8_BAR; PG8_MMA(0, 0, At, B0); PG8_MMA(0, 1, At, B1); PG8_BAR; PG8_SCHED;
            PG8_LDA(At, 0, 1); PG8_STAGE(PG8_SB(0, 0), b2, voffB); PG8_STAGE(PG8_SB(0, 1), b2 + hB, voffB); PG8_STAGE(PG8_SA(0, 0), a2, voffA);
            PG8_WAIT_V(8); PG8_WAIT_L(0); PG8_BAR; PG8_MMA(1, 0, At, B0); PG8_MMA(1, 1, At, B1); PG8_BAR; PG8_SCHED;
            PG8_LDB(B0, 1, 0); PG8_LDB(B1, 1, 1); PG8_SCHED; PG8_LDA(At, 1, 0); PG8_STAGE(PG8_SA(0, 1), a2 + hA, voffA);
            PG8_WAIT_V(8); PG8_WAIT_L(0); PG8_BAR; PG8_MMA(0, 0, At, B0); PG8_MMA(0, 1, At, B1); PG8_BAR; PG8_SCHED;
            PG8_LDA(At, 1, 1); PG8_STAGE(PG8_SB(1, 0), b3, voffB); PG8_STAGE(PG8_SB(1, 1), b3 + hB, voffB); PG8_STAGE(PG8_SA(1, 0), a3, voffA);
            PG8_WAIT_V(8); PG8_WAIT_L(0); PG8_BAR; PG8_MMA(1, 0, At, B0); PG8_MMA(1, 1, At, B1); PG8_BAR; PG8_SCHED;
            } else {
            PG8_LDB(B0, 0, 0); PG8_SCHED; PG8_LDA(At, 0, 0); PG8_STAGE(PG8_SA(1, 1), a1 + hA, voffA);
            PG8_WAIT_L(8); PG8_BAR; PG8_WAIT_L(0); PG8_MMA(0, 0, At, B0); PG8_BAR; PG8_SCHED;
            PG8_LDB(B1, 0, 1); PG8_STAGE(PG8_SB(0, 0), b2, voffB);
            PG8_BAR; PG8_WAIT_L(0); PG8_MMA(0, 1, At, B1); PG8_BAR;
            PG8_LDA(At, 0, 1); PG8_STAGE(PG8_SA(0, 0), a2, voffA);
            PG8_BAR; PG8_WAIT_L(0); PG8_MMA(1, 0, At, B0); PG8_BAR; PG8_SCHED;
            PG8_STAGE(PG8_SB(0, 1), b2 + hB, voffB);
            PG8_WAIT_V(6); PG8_BAR; PG8_MMA(1, 1, At, B1); PG8_BAR;
            PG8_LDB(B0, 1, 0); PG8_SCHED; PG8_LDA(At, 1, 0); PG8_STAGE(PG8_SA(0, 1), a2 + hA, voffA);
            PG8_WAIT_L(8); PG8_BAR; PG8_WAIT_L(0); PG8_MMA(0, 0, At, B0); PG8_BAR; PG8_SCHED;
            PG8_LDB(B1, 1, 1); PG8_STAGE(PG8_SB(1, 0), b3, voffB);
            PG8_BAR; PG8_WAIT_L(0); PG8_MMA(0, 1, At, B1); PG8_BAR;
            PG8_LDA(At, 1, 1); PG8_STAGE(PG8_SA(1, 0), a3, voffA);
            PG8_BAR; PG8_WAIT_L(0); PG8_MMA(1, 0, At, B0); PG8_BAR; PG8_SCHED;
            PG8_STAGE(PG8_SB(1, 1), b3 + hB, voffB);
            PG8_WAIT_V(6); PG8_BAR; PG8_MMA(1, 1, At, B1); PG8_BAR;
            }
        }
        if constexpr (ALIGN_EPI) { if (wr == 0) PG8_BAR; }
        E(acc, cur, wr, wc, fr, fq);
        if (!has_next) break;
#pragma unroll
        for (int a = 0; a < 2; ++a)
#pragma unroll
            for (int b = 0; b < 2; ++b)
#pragma unroll
                for (int m = 0; m < 4; ++m)
#pragma unroll
                    for (int n = 0; n < 2; ++n) acc[a][b][m][n] = (f32x4){0.f, 0.f, 0.f, 0.f};
        cur = nxt; cA = nA; cB = nB; ++ui;
        if constexpr (ALIGN_EPI) { if (wr == 1) PG8_BAR; }
    }
    PG8_WAIT_V(0);
    if constexpr (!ALIGN_EPI) { if (wr == 0) PG8_BAR; }
    PG8_BAR;
#undef PG8_SA
#undef PG8_SB
#undef PG8_STAGE
#undef PG8_LDA
#undef PG8_LDB
#undef PG8_MMA
#undef PG8_WAIT_V
#undef PG8_WAIT_L
#undef PG8_BAR
#undef PG8_SCHED
}
}

constexpr size_t MiB = 1u << 20;
constexpr size_t WS_SS1 = 0, WS_SS2 = 65536, WS_SS3 = 131072, WS_A16 = 262144, WS_BAR = 524288, WS_PCNT = 524288 + 16384;
constexpr size_t WS_WGU1 = 1 * MiB, WS_WD1 = 45 * MiB, WS_WIN = 67 * MiB, WS_WGLU = 83 * MiB, WS_WOUT = 85 * MiB, WS_WGU2 = 93 * MiB, WS_WD2 = 137 * MiB;
constexpr size_t WS_TQ = 159 * MiB, WS_PM = 171 * MiB, WS_XN = 175 * MiB, WS_ACT = 239 * MiB, WS_KN = 415 * MiB, WS_END = 416 * MiB;
constexpr size_t WS_QKVU = WS_ACT, WS_UP = WS_ACT + 128 * MiB;
constexpr int LDS_BYTES = 131072 + 16384;

struct Args { const float* in[28]; float* out; unsigned char* ws; int ph_lo, ph_hi; };

__device__ __forceinline__ int drow_map(int n, int mode) { return mode == 0 ? n : ((n >> 7) * 256 + (n & 127) + (mode == 2 ? 128 : 0)); }
__device__ __forceinline__ void tr_item(const float* __restrict__ W, int K, int N, bf16_t* WT, const float* __restrict__ ksc, int mode, LAS float* scr, int item, int lane) {
    const int nblk = N / 32, kb = item / nblk, nb = item % nblk, k0 = 64 * kb, n0 = 32 * nb;
    const int r8 = lane >> 3, c4 = lane & 7;
    f32x4 v[8];
#pragma unroll
    for (int i = 0; i < 8; ++i) v[i] = *(const f32x4*)(W + (size_t)(k0 + 8 * i + r8) * N + n0 + 4 * c4);
    if (ksc) {
#pragma unroll
        for (int i = 0; i < 8; ++i) v[i] = v[i] * ksc[k0 + 8 * i + r8];
    }
#pragma unroll
    for (int i = 0; i < 8; ++i) { LAS float* d = scr + (8 * i + r8) * 33 + 4 * c4; d[0] = v[i][0]; d[1] = v[i][1]; d[2] = v[i][2]; d[3] = v[i][3]; }
    asm volatile("s_waitcnt lgkmcnt(0)" ::: "memory");
    const int c = lane & 7;
#pragma unroll
    for (int j = 0; j < 4; ++j) { const int n = (lane >> 3) + 8 * j; const LAS float* s = scr + (8 * c) * 33 + n;
        u32x4 o; o.x = cvt_pk_bf16(s[0 * 33], s[1 * 33]); o.y = cvt_pk_bf16(s[2 * 33], s[3 * 33]); o.z = cvt_pk_bf16(s[4 * 33], s[5 * 33]); o.w = cvt_pk_bf16(s[6 * 33], s[7 * 33]);
        *(u32x4*)(WT + (size_t)drow_map(n0 + n, mode) * K + k0 + 8 * c) = o; }
    asm volatile("s_waitcnt lgkmcnt(0)" ::: "memory");
}

__device__ __forceinline__ int crow(int r, int hi) { return (r & 3) + 8 * (r >> 2) + 4 * hi; }
__device__ __forceinline__ s16x4 tr_read(LAS const char* p) {
    typedef short v4i16_t __attribute__((ext_vector_type(4)));
    return __builtin_bit_cast(s16x4, __builtin_amdgcn_ds_read_tr16_b64_v4i16((LAS v4i16_t*)p));
}
__device__ __forceinline__ void attn_unit(int b, int h, int qb, const bf16_t* QKVU, bf16_t* Obuf, int ldo, const float* __restrict__ knorm2, LAS unsigned char* lds, float lam, const float* __restrict__ subln_g) {
    const int tid = threadIdx.x, lane = tid & 63, wid = __builtin_amdgcn_readfirstlane(tid >> 6), comp = wid >> 2, qw = wid & 3, r32 = lane & 31, hi = lane >> 5;
    const size_t rowbase = (size_t)b * SEQ;
    const int q0 = qb * 128, qpos = q0 + 32 * qw + r32, qmin = q0 + 32 * qw;
    const bf16_t* Qp = QKVU + (rowbase + qpos) * DIN + h * 128 + comp * 64;
    bf16x8 qr[4];
#pragma unroll
    for (int d0 = 0; d0 < 4; ++d0) qr[d0] = *(const bf16x8*)(Qp + d0 * 16 + hi * 8);
    const float slope2 = exp2f(-(float)(h + 1)) * LOG2E;
    const int NT = 2 * qb + 2;
    const bf16_t* Kg = QKVU + rowbase * DIN + 1024 + h * 128;
    const bf16_t* Vg = QKVU + rowbase * DIN + 2048 + h * 128;
    const int krow = 8 * wid + (lane >> 3), kpc = lane & 7, kchk = kpc ^ ((krow >> 1) & 7);
    const int vrw0 = 4 * wid + (lane >> 4), vrw1 = vrw0 + 32, vpc = lane & 15;
    const int vchk0 = vpc ^ (((vrw0 & 3) << 2) | ((vrw0 >> 2) & 3)), vchk1 = vpc ^ (((vrw1 & 3) << 2) | ((vrw1 >> 2) & 3));
    const bf16_t* ksrc = Kg + (size_t)krow * DIN + kchk * 8;
    const bf16_t* vsrc0 = Vg + (size_t)vrw0 * DIN + vchk0 * 8;
    const bf16_t* vsrc1 = Vg + (size_t)vrw1 * DIN + vchk1 * 8;
#define ATT_DMA(t, buf) do { const size_t go_ = (size_t)(t) * 64 * DIN; LAS unsigned char* sb_ = lds + ((buf) & 3) * 32768 + wid * 1024; \
        __builtin_amdgcn_global_load_lds((const unsigned*)(ksrc + go_), (LAS unsigned*)(sb_), 16, 0, 0); \
        __builtin_amdgcn_global_load_lds((const unsigned*)(ksrc + go_ + 64), (LAS unsigned*)(sb_ + 8192), 16, 0, 0); \
        __builtin_amdgcn_global_load_lds((const unsigned*)(vsrc0 + go_), (LAS unsigned*)(sb_ + 16384), 16, 0, 0); \
        __builtin_amdgcn_global_load_lds((const unsigned*)(vsrc1 + go_), (LAS unsigned*)(sb_ + 24576), 16, 0, 0); } while (0)
    LAS float* red = (LAS float*)(lds + 131072 + 128);
    LAS unsigned* actf = (LAS unsigned*)(lds + 131072 + 256);
    { const float* kn = knorm2 + (size_t)(b * 16 + 2 * h + comp) * SEQ; const int tq = tid & 255; float mx = 0.f;
      f32x4 knv[4];
#pragma unroll
      for (int j = 0; j < 4; ++j) knv[j] = *(const f32x4*)(kn + (j * 256 + tq) * 4);
      ATT_DMA(NT - 1, (NT - 1) & 3); ATT_DMA(NT >= 2 ? NT - 2 : 0, (NT - 2) & 3); ATT_DMA(NT >= 3 ? NT - 3 : 0, (NT - 3) & 3);
#pragma unroll
      for (int j = 0; j < 4; ++j) { const f32x4 v = knv[j]; mx = fmaxf(fmaxf(mx, fmaxf(v[0], v[1])), fmaxf(v[2], v[3])); }
#pragma unroll
      for (int o = 1; o < 64; o <<= 1) mx = fmaxf(mx, __shfl_xor(mx, o));
      if (lane == 0) red[wid] = mx;
      if (tid < 64) actf[tid] = 0u; }
    int vaddr[4][2];
    { const int i16 = lane & 15, q4 = i16 >> 2, p4 = i16 & 3, blk = (lane >> 4) & 1;
#pragma unroll
      for (int dblk = 0; dblk < 4; ++dblk)
#pragma unroll
        for (int ih = 0; ih < 2; ++ih) { const int row = 4 * hi + q4 + 8 * ih, ch = 4 * dblk + 2 * blk + (p4 >> 1), sw = ((row & 3) << 2) | ((row >> 2) & 3);
            vaddr[dblk][ih] = 16384 + row * 256 + ((ch ^ sw) << 4) + 8 * (p4 & 1); } }
    const int kaoff = r32 * 128, ksw = (r32 >> 1) & 7;
    f32x16 o[4];
#pragma unroll
    for (int d = 0; d < 4; ++d)
#pragma unroll
        for (int r = 0; r < 16; ++r) o[d][r] = 0.f;
    float qn = 0.f;
#pragma unroll
    for (int d0 = 0; d0 < 4; ++d0)
#pragma unroll
        for (int j = 0; j < 8; ++j) { const float v = __uint_as_float(((unsigned)(unsigned short)qr[d0][j]) << 16); qn += v * v; }
    qn += __shfl_xor(qn, 32);
    asm volatile("s_waitcnt vmcnt(8) lgkmcnt(0)" ::: "memory");
    __builtin_amdgcn_s_barrier();
    const float kmax = sqrtf(fmaxf(fmaxf(red[4 * comp], red[4 * comp + 1]), fmaxf(red[4 * comp + 2], red[4 * comp + 3])));
    const float bq = sqrtf(qn) * kmax * 1.02f + 1.0f;
    float mrun = 0.f, lrun = 0.f, dq = slope2 * (float)(4 * hi - qpos);
    bool first = true, active = true;
    for (int t = NT - 1; t >= 0; --t) {
        const int buf = t & 3;
        ATT_DMA(t >= 3 ? t - 3 : 0, (t - 3) & 3);
        const int kv0 = t * 64;
        if (active && kv0 <= qmin + 31) {
            const int dmin = qmin - (kv0 + 63);
            if (!first && dmin > 0 && __all((bq - mrun) < slope2 * (float)dmin - 150.0f)) {
                active = false;
            } else {
            LAS const unsigned char* Kb = lds + buf * 32768 + comp * 8192;
            LAS const unsigned char* Sb = lds + buf * 32768;
            f32x16 p0, p1;
            const float dqt = dq + slope2 * (float)kv0;
#pragma unroll
            for (int r = 0; r < 16; ++r) { p0[r] = fmaf(slope2, (float)((r & 3) + 8 * (r >> 2)), dqt); p1[r] = fmaf(slope2, (float)(32 + (r & 3) + 8 * (r >> 2)), dqt); }
            bf16x8 k0f[4], k1f[4];
#pragma unroll
            for (int d0 = 0; d0 < 4; ++d0) {
                const int csw = ((2 * d0 + hi) ^ ksw) << 4;
                k0f[d0] = *(LAS const bf16x8*)(Kb + kaoff + csw);
                k1f[d0] = *(LAS const bf16x8*)(Kb + 4096 + kaoff + csw);
            }
            __builtin_amdgcn_sched_barrier(0);
#pragma unroll
            for (int d0 = 0; d0 < 4; ++d0) {
                p0 = __builtin_amdgcn_mfma_f32_32x32x16_bf16(k0f[d0], qr[d0], p0, 0, 0, 0);
                p1 = __builtin_amdgcn_mfma_f32_32x32x16_bf16(k1f[d0], qr[d0], p1, 0, 0, 0);
            }
            bf16x8 va[4], vb[4];
#define ATT_VREAD(dst, s_) do { _Pragma("unroll") for (int dblk = 0; dblk < 4; ++dblk) { \
                const s16x4 lo_ = tr_read((LAS const char*)(Sb + vaddr[dblk][0] + (s_) * 4096)); const s16x4 hv_ = tr_read((LAS const char*)(Sb + vaddr[dblk][1] + (s_) * 4096)); \
                dst[dblk] = (bf16x8){lo_[0], lo_[1], lo_[2], lo_[3], hv_[0], hv_[1], hv_[2], hv_[3]}; } } while (0)
#define ATT_PV(src, s_) do { _Pragma("unroll") for (int dblk = 0; dblk < 4; ++dblk) o[dblk] = __builtin_amdgcn_mfma_f32_32x32x16_bf16(src[dblk], pf[s_], o[dblk], 0, 0, 0); } while (0)
            ATT_VREAD(va, 0); ATT_VREAD(vb, 1);
            __builtin_amdgcn_sched_barrier(0);
            if (kv0 + 63 > qmin) {
#pragma unroll
                for (int r = 0; r < 16; ++r) { const int kv = kv0 + crow(r, hi); if (kv > qpos) p0[r] = -INFINITY; if (kv + 32 > qpos) p1[r] = -INFINITY; }
            }
            float x = fmaxf(p0[0], p1[0]);
#pragma unroll
            for (int r = 1; r < 16; ++r) x = fmaxf(fmaxf(x, p0[r]), p1[r]);
            x = fmaxf(x, __shfl_xor(x, 32));
            if (first || __any(x > 0.f)) {
                const float xp = first ? x : fmaxf(x, 0.f);
                mrun += xp; dq -= xp;
                const float alpha = __builtin_amdgcn_exp2f(-xp);
                lrun *= alpha;
#pragma unroll
                for (int r = 0; r < 16; ++r) { p0[r] -= xp; p1[r] -= xp; }
                if (!first) {
#pragma unroll
                    for (int d = 0; d < 4; ++d)
#pragma unroll
                        for (int r = 0; r < 16; ++r) o[d][r] *= alpha;
                }
                first = false;
            }
            float sum = 0.f;
#pragma unroll
            for (int r = 0; r < 16; ++r) { p0[r] = __builtin_amdgcn_exp2f(p0[r]); p1[r] = __builtin_amdgcn_exp2f(p1[r]); sum += p0[r] + p1[r]; }
            lrun += sum;
            bf16x8 pf[4];
#pragma unroll
            for (int s = 0; s < 4; ++s) {
                u32x4 w;
                if (s < 2) { w.x = cvt_pk_bf16_b(p0[8 * s + 0], p0[8 * s + 1]); w.y = cvt_pk_bf16_b(p0[8 * s + 2], p0[8 * s + 3]); w.z = cvt_pk_bf16_b(p0[8 * s + 4], p0[8 * s + 5]); w.w = cvt_pk_bf16_b(p0[8 * s + 6], p0[8 * s + 7]); }
                else { const int s2 = s - 2; w.x = cvt_pk_bf16_b(p1[8 * s2 + 0], p1[8 * s2 + 1]); w.y = cvt_pk_bf16_b(p1[8 * s2 + 2], p1[8 * s2 + 3]); w.z = cvt_pk_bf16_b(p1[8 * s2 + 4], p1[8 * s2 + 5]); w.w = cvt_pk_bf16_b(p1[8 * s2 + 6], p1[8 * s2 + 7]); }
                pf[s] = __builtin_bit_cast(bf16x8, w);
            }
            __builtin_amdgcn_sched_barrier(0);
            ATT_PV(va, 0); __builtin_amdgcn_sched_barrier(0);
            ATT_VREAD(va, 2); __builtin_amdgcn_sched_barrier(0);
            ATT_PV(vb, 1); __builtin_amdgcn_sched_barrier(0);
            ATT_VREAD(vb, 3); __builtin_amdgcn_sched_barrier(0);
            ATT_PV(va, 2); __builtin_amdgcn_sched_barrier(0);
            ATT_PV(vb, 3);
#undef ATT_VREAD
#undef ATT_PV
            }
        }
        if (active && lane == 0) actf[t] = 1u;
        asm volatile("s_waitcnt vmcnt(8) lgkmcnt(0)" ::: "memory");
        __builtin_amdgcn_s_barrier();
        if (*(volatile LAS unsigned*)(actf + t) == 0u) break;
    }
#undef ATT_DMA
    lrun += __shfl_xor(lrun, 32);
    const float inv = 1.0f / lrun;
    LAS float* X = (LAS float*)lds;
    asm volatile("s_waitcnt vmcnt(0)" ::: "memory");
    __syncthreads();
    if (comp == 1) {
#pragma unroll
        for (int d = 0; d < 4; ++d)
#pragma unroll
            for (int r = 0; r < 16; ++r) X[(32 * d + crow(r, hi)) * 128 + 32 * qw + r32] = o[d][r] * inv;
    }
    __syncthreads();
    if (comp == 0) {
        float ssq = 0.f;
        f32x16 xv[4];
#pragma unroll
        for (int d = 0; d < 4; ++d)
#pragma unroll
            for (int r = 0; r < 16; ++r) xv[d][r] = X[(32 * d + crow(r, hi)) * 128 + 32 * qw + r32];
        __builtin_amdgcn_sched_barrier(0);
#pragma unroll
        for (int d = 0; d < 4; ++d)
#pragma unroll
            for (int r = 0; r < 16; ++r) { const float v = o[d][r] * inv - lam * xv[d][r]; o[d][r] = v; ssq += v * v; }
        ssq += __shfl_xor(ssq, 32);
        const float sc = rsqrtf(ssq * (1.0f / 128.0f) + SUBLN_EPS) * (1.0f - LAMBDA_INIT);
        bf16_t* Op = Obuf + (rowbase + qpos) * (size_t)ldo + h * 128;
        f32x4 g4v[4][4];
#pragma unroll
        for (int d = 0; d < 4; ++d)
#pragma unroll
            for (int rg = 0; rg < 4; ++rg) g4v[d][rg] = *(const f32x4*)(subln_g + 32 * d + 8 * rg + 4 * hi);
#pragma unroll
        for (int d = 0; d < 4; ++d)
#pragma unroll
            for (int rg = 0; rg < 4; ++rg) { const int dd = 32 * d + 8 * rg + 4 * hi; const f32x4 g4 = g4v[d][rg];
                u32x2 w; w.x = cvt_pk_bf16(o[d][4 * rg + 0] * sc * g4[0], o[d][4 * rg + 1] * sc * g4[1]); w.y = cvt_pk_bf16(o[d][4 * rg + 2] * sc * g4[2], o[d][4 * rg + 3] * sc * g4[3]);
                *(u32x2*)(Op + dd) = w; }
    }
    __syncthreads();
}

__device__ __forceinline__ float gelu_tanh(float x) {
    const float z = 0.7978845608028654f * (x + 0.044715f * x * x * x);
    return x * __builtin_amdgcn_rcpf(1.0f + __expf(-2.0f * z));
}
__device__ __forceinline__ void ssm_unit(int b, int g, const bf16_t* __restrict__ UP, const bf16_t* __restrict__ TQ, const bf16_t* __restrict__ PM, const float* __restrict__ A16, bf16_t* QKVU, LAS unsigned char* lds, bool do_store = true) {
    const int tid = threadIdx.x, lane = tid & 63, wid = __builtin_amdgcn_readfirstlane(tid >> 6), r32 = lane & 31, hi = lane >> 5;
    LAS unsigned char* UQ = lds;
    LAS float* XL = (LAS float*)(lds + 33792);
    LAS unsigned char* XI = lds + 66560;
    const bf16_t* Ub = UP + (size_t)(b * NGRP + g) * (SEQ * HGC);
    const bf16_t* TQg = TQ + (size_t)g * 256 * 384;
    const bf16_t* PMg = PM + (size_t)g * 128 * 256;
    const float a16r = A16[(g * NST + lane) * 2], a16i = A16[(g * NST + lane) * 2 + 1];
    const int rb1 = wid >> 2, cb1 = wid & 3;
    bf16x8 tq[16];
    const bf16_t* Tp = TQg + (size_t)(32 * wid + r32) * 384 + 8 * hi;
#pragma unroll
    for (int ks = 0; ks < 16; ++ks) tq[ks] = *(const bf16x8*)(Tp + 16 * ks);
    const bf16_t* Pp = PMg + (size_t)(32 * cb1 + r32) * 256 + 8 * hi;
    float sr = 0.f, si = 0.f;
    for (int qi = 0; qi < 4; ++qi) {
        { u32x4 un[4];
#pragma unroll
          for (int j = 0; j < 4; ++j) un[j] = *(const u32x4*)(Ub + (size_t)qi * 16384 + (size_t)(j * 512 + tid) * 8);
#pragma unroll
          for (int j = 0; j < 4; ++j) { const int idx = j * 512 + tid, row = idx >> 5, cc = idx & 31; *(LAS u32x4*)(UQ + row * 528 + cc * 16) = un[j]; } }
        bf16x8 pm[16];
#pragma unroll
        for (int ks = 0; ks < 16; ++ks) pm[ks] = *(const bf16x8*)(Pp + 16 * ks);
        __syncthreads();
        { f32x16 acc;
#pragma unroll
          for (int r = 0; r < 16; ++r) acc[r] = 0.f;
          LAS const unsigned char* ua = UQ + (32 * rb1 + r32) * 528 + 16 * hi;
          bf16x8 fa[4];
#define SSM_XLD(dst, g_) do { _Pragma("unroll") for (int i_ = 0; i_ < 4; ++i_) dst[i_] = *(LAS const bf16x8*)(ua + 32 * (4 * (g_) + i_)); } while (0)
#define SSM_XMM(src, g_) do { _Pragma("unroll") for (int i_ = 0; i_ < 4; ++i_) acc = __builtin_amdgcn_mfma_f32_32x32x16_bf16(src[i_], pm[4 * (g_) + i_], acc, 0, 0, 0); } while (0)
#pragma unroll
          for (int g4 = 0; g4 < 4; ++g4) { SSM_XLD(fa, g4); __builtin_amdgcn_sched_barrier(0); SSM_XMM(fa, g4); __builtin_amdgcn_sched_barrier(0); }
#undef SSM_XLD
#undef SSM_XMM
#pragma unroll
          for (int r = 0; r < 16; ++r) XL[(32 * rb1 + crow(r, hi)) * 128 + 32 * cb1 + r32] = acc[r]; }
        bf16x8 qf[8];
#pragma unroll
        for (int ks = 0; ks < 8; ++ks) qf[ks] = *(const bf16x8*)(Tp + 256 + 16 * ks);
        __syncthreads();
        if (wid == 0) {
            for (int c0 = 0; c0 < 64; c0 += 8) {
                float xr[8], xi[8];
#pragma unroll
                for (int j = 0; j < 8; ++j) { xr[j] = XL[(c0 + j) * 128 + lane]; xi[j] = XL[(c0 + j) * 128 + 64 + lane]; }
#pragma unroll
                for (int j = 0; j < 8; ++j) {
                    *(LAS unsigned short*)(XI + (c0 + j) * 272 + lane * 2) = (unsigned short)(cvt_pk_bf16(sr, 0.f) & 0xffffu);
                    *(LAS unsigned short*)(XI + (c0 + j) * 272 + 128 + lane * 2) = (unsigned short)(cvt_pk_bf16(si, 0.f) & 0xffffu);
                    const float nr = a16r * sr - a16i * si + xr[j], ni = a16r * si + a16i * sr + xi[j];
                    sr = nr; si = ni;
                }
            }
        }
        __syncthreads();
        { f32x16 acc[2];
#pragma unroll
          for (int rb = 0; rb < 2; ++rb)
#pragma unroll
            for (int r = 0; r < 16; ++r) acc[rb][r] = 0.f;
          LAS const unsigned char* ya = UQ + r32 * 528 + 16 * hi;
          LAS const unsigned char* yx = XI + r32 * 272 + 16 * hi;
          bf16x8 fa[4];
#define SSM_YLD(dst, g_) do { _Pragma("unroll") for (int i_ = 0; i_ < 2; ++i_) _Pragma("unroll") for (int rb = 0; rb < 2; ++rb) { const int ks_ = 2 * (g_) + i_; \
              dst[2 * i_ + rb] = (ks_ < 16) ? *(LAS const bf16x8*)(ya + rb * (32 * 528) + 32 * ks_) : *(LAS const bf16x8*)(yx + rb * (32 * 272) + 32 * (ks_ - 16)); } } while (0)
#define SSM_YMM(src, g_) do { _Pragma("unroll") for (int i_ = 0; i_ < 2; ++i_) _Pragma("unroll") for (int rb = 0; rb < 2; ++rb) { const int ks_ = 2 * (g_) + i_; \
              acc[rb] = __builtin_amdgcn_mfma_f32_32x32x16_bf16(src[2 * i_ + rb], (ks_ < 16) ? tq[ks_ & 15] : qf[ks_ & 7], acc[rb], 0, 0, 0); } } while (0)
#pragma unroll
          for (int g2 = 0; g2 < 12; ++g2) { SSM_YLD(fa, g2); __builtin_amdgcn_sched_barrier(0); SSM_YMM(fa, g2); __builtin_amdgcn_sched_barrier(0); }
#undef SSM_YLD
#undef SSM_YMM
          LAS unsigned short* YS = (LAS unsigned short*)XL;
#pragma unroll
          for (int rb = 0; rb < 2; ++rb)
#pragma unroll
            for (int r = 0; r < 16; ++r) { const int c = 32 * rb + crow(r, hi);
                const float gv = gelu_tanh(acc[rb][r]);
                YS[c * 256 + 32 * wid + r32] = (unsigned short)(cvt_pk_bf16(gv, 0.f) & 0xffffu); } }
        __syncthreads();
        if (do_store) {
#pragma unroll
        for (int j = 0; j < 4; ++j) { const int id = j * 512 + tid, c = id >> 5, pos = id & 31, tau = pos >> 1, h8 = (pos & 1) * 8;
            const u32x4 v = *(LAS const u32x4*)((LAS const unsigned char*)XL + c * 512 + pos * 16);
            *(u32x4*)(QKVU + ((size_t)b * SEQ + (size_t)(64 * qi + c) * 16 + tau) * DIN + 3072 + g * HGC + h8) = v; }
        }
        __syncthreads();
    }
}

#define XB_TMO      128
#define XB_XCNT(j)  (256  + 64 * (j))
#define XB_XSUB(j)  (1280 + 64 * (j))
#define XB_XGEN(j)  (2304 + 64 * (j))
#define XB_TOP      3328
#define XB_TOPGEN   3392
#define XCD_BAR_WORDS 3456
#define XB_SPIN_CAP (1u << 18)
__device__ __forceinline__ unsigned xb_ld(unsigned* p)              { return __hip_atomic_load(p, __ATOMIC_RELAXED, __HIP_MEMORY_SCOPE_AGENT); }
__device__ __forceinline__ unsigned xb_add(unsigned* p, unsigned v) { return __hip_atomic_fetch_add(p, v, __ATOMIC_RELAXED, __HIP_MEMORY_SCOPE_AGENT); }
__device__ __forceinline__ unsigned xb_xcc_id() { return (unsigned)__builtin_amdgcn_s_getreg((3 << 11) | 20) & 0xFu; }
#define XB_SPIN(cond, bar) do { unsigned _sp = 0; while (cond) { __builtin_amdgcn_s_sleep(1); \
    if ((++_sp & 255u) == 0u) { if (xb_ld(&(bar)[XB_TMO])) break; if (_sp > XB_SPIN_CAP) { atomicAdd(&(bar)[XB_TMO], 1u); break; } } } } while (0)
struct XcdBarrier { unsigned* bar; unsigned x; volatile LAS unsigned* st; };
__device__ __forceinline__ XcdBarrier xcd_barrier_post(unsigned* bar, volatile LAS unsigned* st) {
    XcdBarrier b; b.bar = bar; b.x = xb_xcc_id(); b.st = st;
    if (threadIdx.x == 0) (void)xb_add(&bar[XB_XCNT(b.x)], 1u);
    return b;
}
__device__ __forceinline__ void xcd_barrier_complete(unsigned* bar, unsigned x, unsigned& nloc, unsigned& nx) {
    const unsigned G = gridDim.x * gridDim.y * gridDim.z;
    unsigned sum, cnt, mine, sp = 0u;
    for (;;) {
        sum = 0u; cnt = 0u; mine = 0u;
#pragma unroll
        for (unsigned j = 0; j < 16; ++j) { const unsigned c = xb_ld(&bar[XB_XCNT(j)]); sum += c; cnt += (c > 0u) ? 1u : 0u; mine = (j == x) ? c : mine; }
        if (sum == G) break;
        __builtin_amdgcn_s_sleep(1);
        if ((++sp & 255u) == 0u) { if (xb_ld(&bar[XB_TMO])) break; if (sp > XB_SPIN_CAP) { atomicAdd(&bar[XB_TMO], 1u); break; } }
    }
    nloc = mine > 0u ? mine : 1u; nx = cnt > 0u ? cnt : 1u;
}
__device__ __forceinline__ void xcd_barrier(const XcdBarrier& b) {
    asm volatile("s_waitcnt vmcnt(0)" ::: "memory");
    __syncthreads();
    if (threadIdx.x == 0) {
        unsigned* bar = b.bar;
        __builtin_amdgcn_s_waitcnt(0);
        unsigned nloc = b.st[0], nx = b.st[1];
        if (nloc == 0u) { xcd_barrier_complete(bar, b.x, nloc, nx); b.st[0] = nloc; b.st[1] = nx; }
        const unsigned old = xb_add(&bar[XB_XSUB(b.x)], 1u);
        const unsigned gen = old / nloc;
        if (old + 1u == (gen + 1u) * nloc) {
            __builtin_amdgcn_fence(__ATOMIC_RELEASE, "agent");
            asm volatile("s_waitcnt vmcnt(0)" ::: "memory");
            const unsigned og = xb_add(&bar[XB_TOP], 1u);
            const unsigned tg = og / nx;
            if (og + 1u == (tg + 1u) * nx) xb_add(&bar[XB_TOPGEN], 1u);
            else XB_SPIN(xb_ld(&bar[XB_TOPGEN]) == tg, bar);
            __builtin_amdgcn_fence(__ATOMIC_ACQUIRE, "agent");
            xb_add(&bar[XB_XGEN(b.x)], 1u);
            asm volatile("s_waitcnt vmcnt(0)" ::: "memory");
        } else {
            XB_SPIN(xb_ld(&bar[XB_XGEN(b.x)]) == gen, bar);
            __builtin_amdgcn_fence(__ATOMIC_ACQUIRE, "agent");
            asm volatile("s_waitcnt vmcnt(0)" ::: "memory");
        }
    }
    __syncthreads();
}

static __device__ const unsigned att_tab[64] = {173134591u,155831038u,138527485u,2021260023u,1886515958u,1751771893u,1617027836u,1482283764u,3368634095u,3233891822u,3099149549u,2964407276u,2829667815u,2694925542u,2560183269u,120801252u,2425443551u,2290701278u,103960541u,1345277660u,2155961303u,1210996694u,1076713173u,942429652u,808148943u,673865422u,338124237u,321281228u,304441031u,287598022u,4163069125u,4028785604u,469331391u,452029630u,434727869u,88041404u,400651447u,383349686u,71200693u,54357684u,366050223u,37517230u,20674221u,3831212u,540515239u,406229926u,271944613u,255099812u,240827295u,223523742u,206220189u,188916636u,3900365719u,3765621654u,3630877589u,3496133524u,530250639u,512947086u,495643533u,478339980u,968523655u,833781382u,699039109u,564296836u};

__global__ void __launch_bounds__(512, 2) mk_fwd(Args args) {
    extern __shared__ __attribute__((aligned(16))) unsigned char lds_raw[];
    LAS unsigned char* lds = (LAS unsigned char*)lds_raw;
    cg::grid_group grid = cg::this_grid();
    const int tid = threadIdx.x, lane = tid & 63, wave = __builtin_amdgcn_readfirstlane(tid >> 6);
    const int G = gridDim.x, bx = blockIdx.x;
    const int vcu = (G % 8 == 0) ? (bx % 8) * (G / 8) + bx / 8 : bx;
    unsigned char* ws = args.ws;
    const float* x = args.in[0];
    float* out = args.out;
    float* ss1 = (float*)(ws + WS_SS1); float* ss2 = (float*)(ws + WS_SS2); float* ss3 = (float*)(ws + WS_SS3); float* A16 = (float*)(ws + WS_A16);
    bf16_t* Wgu1 = (bf16_t*)(ws + WS_WGU1); bf16_t* Wd1 = (bf16_t*)(ws + WS_WD1); bf16_t* Win = (bf16_t*)(ws + WS_WIN); bf16_t* Wglu = (bf16_t*)(ws + WS_WGLU);
    bf16_t* Wout = (bf16_t*)(ws + WS_WOUT); bf16_t* Wgu2 = (bf16_t*)(ws + WS_WGU2); bf16_t* Wd2 = (bf16_t*)(ws + WS_WD2);
    bf16_t* TQ = (bf16_t*)(ws + WS_TQ); bf16_t* PM = (bf16_t*)(ws + WS_PM); bf16_t* XN = (bf16_t*)(ws + WS_XN); bf16_t* ACT = (bf16_t*)(ws + WS_ACT);
    bf16_t* QKVU = (bf16_t*)(ws + WS_QKVU); bf16_t* UP = (bf16_t*)(ws + WS_UP); float* KN = (float*)(ws + WS_KN);
    const int lo = args.ph_lo, hi_ph = args.ph_hi;
#define IN(k) (lo <= (k) && (k) < hi_ph)
    volatile LAS unsigned* bst = (volatile LAS unsigned*)(lds + 131072 + 64);
    if (tid < 4) bst[tid] = 0u;
    __syncthreads();
    unsigned* barw = (unsigned*)(ws + WS_BAR);
    if (args.ph_lo < 0) grid.sync();
    XcdBarrier xbar = xcd_barrier_post(barw, bst);
#define SEAM(k) do { if (IN(k) && IN((k) + 1)) xcd_barrier(xbar); } while (0)

    if (IN(0)) {
        { LAS float* scr = (LAS float*)(lds + wave * 8448);
          const int gw = vcu * 8 + wave, NGW = G * 8;
          constexpr int I_F = (DM / 64) * (DFF / 32), I_D = (DFF / 64) * (DM / 32), I_IN = (DM / 64) * (DIN / 32), I_GL = (1024 / 64) * (1024 / 32), I_O = (DM / 64) * (DM / 32);
          constexpr int NITEMS = 4 * I_F + 2 * I_D + I_IN + I_GL + I_O;
          for (int it = gw; it < (PROBE == 3 ? 2 : 1) * NITEMS; it += NGW) {
              int r = it % NITEMS;
              if (r < I_F) { tr_item(args.in[2], DM, DFF, Wgu1, nullptr, 1, scr, r, lane); continue; } r -= I_F;
              if (r < I_F) { tr_item(args.in[3], DM, DFF, Wgu1, nullptr, 2, scr, r, lane); continue; } r -= I_F;
              if (r < I_D) { tr_item(args.in[4], DFF, DM, Wd1, nullptr, 0, scr, r, lane); continue; } r -= I_D;
              if (r < I_IN) { tr_item(args.in[6], DM, DIN, Win, args.in[5], 0, scr, r, lane); continue; } r -= I_IN;
              if (r < I_GL) { tr_item(args.in[20], 1024, 1024, Wglu, nullptr, 0, scr, r, lane); continue; } r -= I_GL;
              if (r < I_O) { tr_item(args.in[22], DM, DM, Wout, nullptr, 0, scr, r, lane); continue; } r -= I_O;
              if (r < I_F) { tr_item(args.in[24], DM, DFF, Wgu2, args.in[23], 1, scr, r, lane); continue; } r -= I_F;
              if (r < I_F) { tr_item(args.in[25], DM, DFF, Wgu2, args.in[23], 2, scr, r, lane); continue; } r -= I_F;
              tr_item(args.in[26], DFF, DM, Wd2, nullptr, 0, scr, r, lane);
          }
          const float* g1 = args.in[1];
          f32x4 g1v[8];
#pragma unroll
          for (int j = 0; j < 8; ++j) g1v[j] = *((const f32x4*)g1 + lane + 64 * j);
          for (int m2 = gw; m2 < (PROBE == 8 ? 2 : 1) * MTOK; m2 += NGW) {
              const int m = m2 % MTOK;
              const f32x4* xr = (const f32x4*)(x + (size_t)m * DM) + lane;
              f32x4 v[8]; float s = 0.f;
#pragma unroll
              for (int j = 0; j < 8; ++j) { v[j] = xr[64 * j]; s += (v[j][0] * v[j][0] + v[j][1] * v[j][1]) + (v[j][2] * v[j][2] + v[j][3] * v[j][3]); }
              const float rs = rsqrtf(wave_sum(s) * (1.0f / DM) + NORM_EPS);
              u32x2* o8 = (u32x2*)(XN + (size_t)m * DM) + lane;
#pragma unroll
              for (int j = 0; j < 8; ++j) { const f32x4 gg = g1v[j]; u32x2 w; w.x = cvt_pk_bf16(v[j][0] * rs * gg[0], v[j][1] * rs * gg[1]); w.y = cvt_pk_bf16(v[j][2] * rs * gg[2], v[j][3] * rs * gg[3]); o8[64 * j] = w; }
          }
        }
        for (int i = bx * 512 + tid; i < 3 * MTOK; i += G * 512) ((float*)(ws + WS_SS1))[i] = 0.f;
        for (int i = bx * 512 + tid; i < BATCH * 16 * SEQ; i += G * 512) KN[i] = 0.f;
        __syncthreads();
        if (bx < 256) {
            const int g = bx & 63, part = bx >> 6;
            LAS float* pwr = (LAS float*)lds; LAS float* pwi = pwr + 17 * 64; LAS float* bbr = pwi + 17 * 64; LAS float* bbi = bbr + 1024; LAS float* crr = bbi + 1024; LAS float* cii = crr + 1024; LAS float* Kd = cii + 1024;
            const float* lam_re = args.in[12] + g * NST; const float* lam_im = args.in[13] + g * NST;
            const float dt = expf(args.in[14][g]);
            for (int idx = tid; idx < 17 * 64; idx += 512) { const int d = idx >> 6, p = idx & 63; const float lr = lam_re[p], li = lam_im[p];
                const float mag = expf((float)d * (lr * dt)), ang = (float)d * (li * dt); pwr[idx] = mag * cosf(ang); pwi[idx] = mag * sinf(ang); }
            for (int idx = tid; idx < 1024; idx += 512) { const int p = idx >> 4; const float lr = lam_re[p], li = lam_im[p];
                const float mag = expf(lr * dt), abr = mag * cosf(li * dt), abi = mag * sinf(li * dt), den = lr * lr + li * li;
                const float fr_ = ((abr - 1.0f) * lr + abi * li) / den, fi_ = (abi * lr - (abr - 1.0f) * li) / den;
                const float br = args.in[15][(size_t)g * 1024 + idx], bi = args.in[16][(size_t)g * 1024 + idx];
                bbr[idx] = fr_ * br - fi_ * bi; bbi[idx] = fr_ * bi + fi_ * br;
                crr[idx] = args.in[17][(size_t)g * 1024 + idx]; cii[idx] = args.in[18][(size_t)g * 1024 + idx]; }
            __syncthreads();
            {
              const int d = tid >> 5, h = (tid >> 1) & 15, hb = (tid & 1) * 8; float acc8[8];
#pragma unroll
              for (int j = 0; j < 8; ++j) acc8[j] = 0.f;
              for (int p = 0; p < 64; ++p) { const float cr = crr[h * 64 + p], ci = cii[h * 64 + p], pr = pwr[d * 64 + p], pi = pwi[d * 64 + p];
                  const float er = cr * pr - ci * pi, ei = cr * pi + ci * pr;
                  const f32x4 br0 = *(LAS const f32x4*)(bbr + p * 16 + hb), br1 = *(LAS const f32x4*)(bbr + p * 16 + hb + 4), bi0 = *(LAS const f32x4*)(bbi + p * 16 + hb), bi1 = *(LAS const f32x4*)(bbi + p * 16 + hb + 4);
#pragma unroll
                  for (int j = 0; j < 4; ++j) { acc8[j] += er * br0[j] - ei * bi0[j]; acc8[4 + j] += er * br1[j] - ei * bi1[j]; } }
#pragma unroll
              for (int j = 0; j < 8; ++j) { float a = acc8[j]; if (d == 0 && h == hb + j) a += args.in[19][g * HGC + h]; Kd[d * 256 + h * 16 + hb + j] = a; } }
            __syncthreads();
            bf16_t* TQg = TQ + (size_t)g * 256 * 384; bf16_t* PMg = PM + (size_t)g * 128 * 256;
            for (int ck = tid; ck < 64 * 48; ck += 512) { const int row = 64 * part + ck / 48, c8 = (ck % 48) * 8, tau = row >> 4, h = row & 15; float v[8];
                if (c8 < 256) { const int sg = c8 >> 4, h2 = c8 & 15;
                    if (tau >= sg) { const f32x4 k0 = *(LAS const f32x4*)(Kd + (tau - sg) * 256 + h * 16 + h2), k1 = *(LAS const f32x4*)(Kd + (tau - sg) * 256 + h * 16 + h2 + 4);
#pragma unroll
                        for (int j = 0; j < 4; ++j) { v[j] = k0[j]; v[4 + j] = k1[j]; } }
                    else {
#pragma unroll
                        for (int j = 0; j < 8; ++j) v[j] = 0.f; } }
                else { const bool im = (c8 >= 320); const int p = c8 - (im ? 320 : 256);
                    const f32x4 cr0 = *(LAS const f32x4*)(crr + h * 64 + p), cr1 = *(LAS const f32x4*)(crr + h * 64 + p + 4), ci0 = *(LAS const f32x4*)(cii + h * 64 + p), ci1 = *(LAS const f32x4*)(cii + h * 64 + p + 4);
                    const f32x4 pr0 = *(LAS const f32x4*)(pwr + (tau + 1) * 64 + p), pr1 = *(LAS const f32x4*)(pwr + (tau + 1) * 64 + p + 4), pi0 = *(LAS const f32x4*)(pwi + (tau + 1) * 64 + p), pi1 = *(LAS const f32x4*)(pwi + (tau + 1) * 64 + p + 4);
#pragma unroll
                    for (int j = 0; j < 4; ++j) { v[j] = im ? -(cr0[j] * pi0[j] + ci0[j] * pr0[j]) : (cr0[j] * pr0[j] - ci0[j] * pi0[j]);
                                                  v[4 + j] = im ? -(cr1[j] * pi1[j] + ci1[j] * pr1[j]) : (cr1[j] * pr1[j] - ci1[j] * pi1[j]); } }
                u32x4 w; w.x = cvt_pk_bf16(v[0], v[1]); w.y = cvt_pk_bf16(v[2], v[3]); w.z = cvt_pk_bf16(v[4], v[5]); w.w = cvt_pk_bf16(v[6], v[7]);
                *(u32x4*)(TQg + (size_t)row * 384 + c8) = w; }
            for (int ck = tid; ck < 32 * 32; ck += 512) { const int row = 32 * part + (ck >> 5), c8 = (ck & 31) * 8, sg = c8 >> 4, h2 = c8 & 15, p = row & 63;
                const float pr = pwr[(15 - sg) * 64 + p], pi = pwi[(15 - sg) * 64 + p];
                const f32x4 br0 = *(LAS const f32x4*)(bbr + p * 16 + h2), br1 = *(LAS const f32x4*)(bbr + p * 16 + h2 + 4), bi0 = *(LAS const f32x4*)(bbi + p * 16 + h2), bi1 = *(LAS const f32x4*)(bbi + p * 16 + h2 + 4);
                float v[8];
#pragma unroll
                for (int j = 0; j < 4; ++j) { v[j] = (row < 64) ? (pr * br0[j] - pi * bi0[j]) : (pr * bi0[j] + pi * br0[j]); v[4 + j] = (row < 64) ? (pr * br1[j] - pi * bi1[j]) : (pr * bi1[j] + pi * br1[j]); }
                u32x4 w; w.x = cvt_pk_bf16(v[0], v[1]); w.y = cvt_pk_bf16(v[2], v[3]); w.z = cvt_pk_bf16(v[4], v[5]); w.w = cvt_pk_bf16(v[6], v[7]);
                *(u32x4*)(PMg + (size_t)row * 256 + c8) = w; }
            if (part == 0 && tid < 64) { A16[(g * NST + tid) * 2] = pwr[16 * 64 + tid]; A16[(g * NST + tid) * 2 + 1] = pwi[16 * 64 + tid]; }
        }
        __syncthreads();
    }
    SEAM(0);
#if PROBE == 4
    for (int i = 0; i < 20; ++i) grid.sync();
#endif
    for (int rep1 = 0; rep1 < (PROBE == 5 ? 2 : 1); ++rep1)
    if (IN(1)) {
        pg8::Gemm g{XN, Wgu1, MTOK, 2 * DFF, DM, DM, DM}; pg8::StaticOrder S; S.init(MTOK, 2 * DFF, G, bx);
        pg8::EpiSwiGLU E{ACT, DFF, nullptr};
        pg8::gemm_phase<pg8::EpiSwiGLU, pg8::StaticOrder>(lds, g, S, E);
    }
    SEAM(1);
    if (IN(2)) {
        pg8::Gemm g{ACT, Wd1, MTOK, DM, DFF, DFF, DFF}; pg8::StaticOrder S; S.init(MTOK, DM, G, bx);
        pg8::EpiResid E{x, out, XN, ss1, 0.5f, (LAS float*)(lds + 131072 + 4096)};
        pg8::gemm_phase<pg8::EpiResid, pg8::StaticOrder>(lds, g, S, E);
    }
    SEAM(2);
    for (int rep3 = 0; rep3 < (PROBE == 7 ? 2 : 1); ++rep3)
    if (IN(3)) {
        pg8::Gemm g{XN, Win, MTOK, DIN, DM, DM, DM}; pg8::StaticOrder S; S.init(MTOK, DIN, G, bx);
        pg8::EpiWin E{QKVU, UP, ss1, KN, (LAS float*)(lds + 131072 + 8192)};
        pg8::gemm_phase<pg8::EpiWin, pg8::StaticOrder>(lds, g, S, E);
    }
    SEAM(3);
    if (IN(4)) {
        float lam;
        { const float a = wave_sum(args.in[7][lane] * args.in[8][lane]), c = wave_sum(args.in[9][lane] * args.in[10][lane]); lam = expf(a) - expf(c) + LAMBDA_INIT; }
        for (int cu = vcu; cu < 256; cu += G) {
            const int b = cu >> 6; const unsigned e = att_tab[cu & 63];
            for (int ui = 0; ui < 4; ++ui) {
                const unsigned u8 = (e >> (8 * ui)) & 255u;
                attn_unit(b, (int)(u8 & 7u), (int)(u8 >> 3), QKVU, QKVU, DIN, KN, lds, lam, args.in[11]);
            }
        }
        if (bx < 256) {
            ssm_unit(bx >> 6, bx & 63, UP, TQ, PM, A16, QKVU, lds, true);
#if PROBE == 2
            ssm_unit(bx >> 6, bx & 63, UP, TQ, PM, A16, QKVU, lds, true);
#endif
#if PROBE == 9
            ssm_unit(bx >> 6, bx & 63, UP, TQ, PM, A16, QKVU, lds, false);
#endif
        }
    }
    SEAM(4);
    for (int rep5 = 0; rep5 < (PROBE == 6 ? 2 : 1); ++rep5)
    if (IN(5)) {
        pg8::Gemm g{QKVU + 3072, Wglu, MTOK, 1024, 1024, DIN, 1024}; pg8::StaticOrder S; S.init(MTOK, 1024, G, bx);
        pg8::EpiGlu E{QKVU, args.in[21]};
        pg8::gemm_phase<pg8::EpiGlu, pg8::StaticOrder>(lds, g, S, E);
    }
    SEAM(5);
    if (IN(6)) {
        pg8::Gemm g{QKVU, Wout, MTOK, DM, DM, DIN, DM}; pg8::StaticOrder S; S.init(MTOK, DM, G, bx);
        pg8::EpiResid E{out, out, XN, ss2, 1.0f, (LAS float*)(lds + 131072 + 4096)};
        pg8::gemm_phase<pg8::EpiResid, pg8::StaticOrder>(lds, g, S, E);
    }
    SEAM(6);
    if (IN(7)) {
        pg8::Gemm g{XN, Wgu2, MTOK, 2 * DFF, DM, DM, DM}; pg8::StaticOrder S; S.init(MTOK, 2 * DFF, G, bx);
        pg8::EpiSwiGLU E{ACT, DFF, ss2};
        pg8::gemm_phase<pg8::EpiSwiGLU, pg8::StaticOrder>(lds, g, S, E);
    }
    SEAM(7);
    const bool fused_tail = (G == 256);
    if (IN(8)) {
        pg8::Gemm g{ACT, Wd2, MTOK, DM, DFF, DFF, DFF};
        if (fused_tail) {
            pg8::FusedOrder S{bx};
            pg8::EpiResidNorm E{out, out, ss3, (unsigned*)(ws + WS_PCNT), args.in[27], 0.5f, (LAS float*)(lds + 131072 + 4096)};
            pg8::gemm_phase<pg8::EpiResidNorm, pg8::FusedOrder>(lds, g, S, E);
        } else {
            pg8::StaticOrder S; S.init(MTOK, DM, G, bx);
            pg8::EpiResid E{out, out, nullptr, ss3, 0.5f, (LAS float*)(lds + 131072 + 4096)};
            pg8::gemm_phase<pg8::EpiResid, pg8::StaticOrder>(lds, g, S, E);
        }
    }
    if (!fused_tail) SEAM(8);
    if (IN(9) && !fused_tail) {
        const float* gf = args.in[27];
        const int gw = vcu * 8 + wave, NGW = G * 8;
        f32x4 ggv[8];
#pragma unroll
        for (int j = 0; j < 8; ++j) ggv[j] = *((const f32x4*)gf + lane + 64 * j);
        for (int m = gw; m < MTOK; m += NGW) {
            const float rs = rsqrtf(ss3[m] * (1.0f / DM) + NORM_EPS);
            f32x4* xr = (f32x4*)(out + (size_t)m * DM) + lane;
            f32x4 v[8];
#pragma unroll
            for (int j = 0; j < 8; ++j) v[j] = xr[64 * j];
#pragma unroll
            for (int j = 0; j < 8; ++j) xr[64 * j] = v[j] * rs * ggv[j];
        }
    }
#undef IN
#undef SEAM
}

#ifndef MK_N_LAUNCHES
#define MK_N_LAUNCHES 1
#endif
constexpr int N_PHASES = 10;

extern "C" void kernel_launch(void* const* d_in, const int* in_sizes, int n_in, void* d_out, int out_size, void* d_ws, size_t ws_size, hipStream_t stream) {
    static int grid = 0;
    if (grid == 0) {
        if (n_in != 28 || ws_size < WS_END) { fprintf(stderr, "kernel_launch: unexpected inputs (n_in %d, ws %zu)\n", n_in, ws_size); grid = -1; return; }
        int dev = 0, cus = 0, per_cu = 0;
        (void)hipGetDevice(&dev);
        (void)hipDeviceGetAttribute(&cus, hipDeviceAttributeMultiprocessorCount, dev);
        (void)hipFuncSetAttribute((const void*)mk_fwd, hipFuncAttributeMaxDynamicSharedMemorySize, LDS_BYTES);
        (void)hipOccupancyMaxActiveBlocksPerMultiprocessor(&per_cu, (const void*)mk_fwd, 512, LDS_BYTES);
        if (per_cu < 1) { fprintf(stderr, "kernel_launch: occupancy query reports %d blocks per CU\n", per_cu); per_cu = 1; }
        (void)hipGetLastError();
        grid = cus;
    }
    if (grid < 0) return;
    if (hipMemsetAsync((char*)d_ws + WS_BAR, 0, 16384 + 64 * 256, stream) != hipSuccess) { fprintf(stderr, "kernel_launch: memset of the barrier words failed\n"); return; }
    Args a{};
    for (int i = 0; i < 28; ++i) a.in[i] = (const float*)d_in[i];
    a.out = (float*)d_out; a.ws = (unsigned char*)d_ws;
#if MK_N_LAUNCHES == 1
    a.ph_lo = 0; a.ph_hi = N_PHASES;
    void* kargs[] = {&a};
    hipError_t e = hipLaunchCooperativeKernel((const void*)mk_fwd, dim3(grid), dim3(512), kargs, LDS_BYTES, stream);
    if (e != hipSuccess) fprintf(stderr, "cooperative launch failed: %s (grid %d)\n", hipGetErrorString(e), grid);
#else
    for (int p = 0; p < N_PHASES; ++p) { a.ph_lo = p; a.ph_hi = p + 1; hipLaunchKernelGGL(mk_fwd, dim3(grid), dim3(512), LDS_BYTES, stream, a); }
#endif
}
```

```cpp
#include <hip/hip_runtime.h>
#include <hip/hip_cooperative_groups.h>
#include <cstdio>
#include <cstdint>
#include <cmath>
namespace cg = cooperative_groups;
#ifndef PROBE
#define PROBE 0
#endif

#define LAS __attribute__((address_space(3)))
typedef unsigned short bf16_t;
typedef short bf16x8 __attribute__((ext_vector_type(8)));
typedef short s16x4 __attribute__((ext_vector_type(4)));
typedef float f32x2 __attribute__((ext_vector_type(2)));
typedef float f32x4 __attribute__((ext_vector_type(4)));
typedef float f32x16 __attribute__((ext_vector_type(16)));
typedef unsigned u32x2 __attribute__((ext_vector_type(2)));
typedef unsigned u32x4 __attribute__((ext_vector_type(4)));

constexpr int BATCH = 4, SEQ = 4096, DM = 2048, MTOK = BATCH * SEQ, DFF = 5632, DIN = 4096;
constexpr int NGRP = 64, NST = 64, HGC = 16;
constexpr float NORM_EPS = 1e-6f, SUBLN_EPS = 1e-5f;
constexpr float LOG2E = 1.4426950408889634f;
constexpr float QSCALE = 0.125f * LOG2E;
constexpr float LAMBDA_INIT = 0.2f;

__device__ __forceinline__ unsigned cvt_pk_bf16(float lo, float hi) { unsigned r; asm volatile("v_cvt_pk_bf16_f32 %0, %1, %2" : "=v"(r) : "v"(lo), "v"(hi)); return r; }
typedef __bf16 bf16x2_t __attribute__((ext_vector_type(2)));
__device__ __forceinline__ unsigned cvt_pk_bf16_b(float lo, float hi) { const f32x2 v = {lo, hi}; const bf16x2_t b = __builtin_convertvector(v, bf16x2_t); return __builtin_bit_cast(unsigned, b); }
__device__ __forceinline__ float bf16_to_f32(unsigned short v) { return __uint_as_float(((unsigned)v) << 16); }
__device__ __forceinline__ float wave_sum(float v) {
#pragma unroll
    for (int o = 1; o < 64; o <<= 1) v += __shfl_xor(v, o);
    return v;
}

namespace pg8 {
constexpr int BM = 256, BK = 64, HALF = 128, HTB = HALF * BK * 2, STAGE_BYTES = 8 * HTB, NXCD = 8, WGM = 8;
__host__ __device__ __forceinline__ int lds_byte(int r, int c) { const int st = (r >> 4) * 2 + (c >> 5), rr = r & 15, cc = c & 31, ob = rr * 64 + cc * 2; return st * 1024 + (ob ^ (((ob >> 9) & 1) << 5)); }
__host__ __device__ __forceinline__ void stage_rc(int b, int& R, int& C) { const int st = b / 1024, sb = b % 1024, swz = sb ^ (((sb >> 9) & 1) << 5); R = (st >> 1) * 16 + swz / 64; C = (st & 1) * 32 + (swz % 64) / 2; }
__host__ __device__ __forceinline__ int perm32(int rho) { const int n = rho >> 4, i = rho & 15; return 8 * (i >> 2) + 4 * n + (i & 3); }

struct Unit { int pm, pn; };
struct Gemm { const bf16_t* A; const bf16_t* Bt; int M, N, K, lda, ldb; };

struct StaticOrder {
    int nM, nN, nwg, G, c;
    __host__ __device__ void init(int M, int N, int G_, int c_) { nM = M / BM; nN = N / BM; nwg = nM * nN; G = G_; c = c_; }
    __host__ __device__ bool next(int i, Unit& u) const {
        const long L = (long)i * G + c; if (L >= nwg) return false;
        int wgid = (int)L; { const int q = nwg / NXCD, r = nwg % NXCD, xcd = wgid % NXCD, off = wgid / NXCD; wgid = (xcd < r ? xcd * (q + 1) : r * (q + 1) + (xcd - r) * q) + off; }
        const int nig = WGM * nN, gid = wgid / nig, fm = gid * WGM, gsz = (nM - fm) < WGM ? (nM - fm) : WGM;
        u.pm = fm + ((wgid % nig) % gsz); u.pn = (wgid % nig) / gsz; return true;
    }
};


struct EpiSwiGLU {
    static constexpr bool PERM = true;
    bf16_t* O; int ldc; const float* ss;
    mutable int pmc = -1; mutable float rsc[2][4] = {};
    __device__ __forceinline__ void operator()(const f32x4 (&acc)[2][2][4][2], const Unit& u, int wr, int wc, int fr, int fq) const {
        const int row0 = u.pm * BM + wr * 64 + fr, col0 = u.pn * HALF + wc * 32 + 8 * fq;
        if (ss && u.pm != pmc) {
            float rsv[2][4];
#pragma unroll
            for (int ai = 0; ai < 2; ++ai)
#pragma unroll
                for (int m = 0; m < 4; ++m) rsv[ai][m] = ss[row0 + ai * HALF + m * 16];
#pragma unroll
            for (int ai = 0; ai < 2; ++ai)
#pragma unroll
                for (int m = 0; m < 4; ++m) rsc[ai][m] = rsqrtf(rsv[ai][m] * (1.0f / DM) + NORM_EPS);
            pmc = u.pm;
        }
#pragma unroll
        for (int ai = 0; ai < 2; ++ai)
#pragma unroll
            for (int m = 0; m < 4; ++m) {
                const int row = row0 + ai * HALF + m * 16;
                const float rs = ss ? rsc[ai][m] : 1.0f;
                float o[8];
#pragma unroll
                for (int n = 0; n < 2; ++n)
#pragma unroll
                    for (int j = 0; j < 4; ++j) { const float gt = acc[ai][0][m][n][j] * rs, up = acc[ai][1][m][n][j] * rs;
                        o[n * 4 + j] = gt * __builtin_amdgcn_rcpf(1.0f + __expf(-gt)) * up; }
                u32x4 w; w.x = cvt_pk_bf16(o[0], o[1]); w.y = cvt_pk_bf16(o[2], o[3]); w.z = cvt_pk_bf16(o[4], o[5]); w.w = cvt_pk_bf16(o[6], o[7]);
                *(u32x4*)(O + (size_t)row * ldc + col0) = w;
            }
    }
};
struct EpiResid {
    static constexpr bool PERM = true;
    const float* base; float* out; bf16_t* xb; float* ss; float alpha; LAS float* part;
    __device__ __forceinline__ void operator()(const f32x4 (&acc)[2][2][4][2], const Unit& u, int wr, int wc, int fr, int fq) const {
        const int row0 = u.pm * BM + wr * 64 + fr, col0 = u.pn * BM + wc * 32 + 8 * fq;
#pragma unroll
        for (int ai = 0; ai < 2; ++ai) {
#pragma unroll
          for (int mh = 0; mh < 2; ++mh) {
          f32x4 bb[2][2][2];
#pragma unroll
          for (int m2 = 0; m2 < 2; ++m2)
#pragma unroll
            for (int bj = 0; bj < 2; ++bj) { const size_t off = (size_t)(row0 + ai * HALF + (2 * mh + m2) * 16) * DM + col0 + bj * HALF;
                bb[m2][bj][0] = *(const f32x4*)(base + off); bb[m2][bj][1] = *(const f32x4*)(base + off + 4); }
#pragma unroll
            for (int m2 = 0; m2 < 2; ++m2) { const int m = 2 * mh + m2;
                const int row = row0 + ai * HALF + m * 16; float sq = 0.f;
#pragma unroll
                for (int bj = 0; bj < 2; ++bj) {
                    const size_t off = (size_t)row * DM + col0 + bj * HALF;
                    const f32x4 b0 = bb[m2][bj][0], b1 = bb[m2][bj][1];
                    const f32x4 v0 = b0 + acc[ai][bj][m][0] * alpha, v1 = b1 + acc[ai][bj][m][1] * alpha;
                    *(f32x4*)(out + off) = v0; *(f32x4*)(out + off + 4) = v1;
                    sq += (v0[0] * v0[0] + v0[1] * v0[1]) + (v0[2] * v0[2] + v0[3] * v0[3]) + (v1[0] * v1[0] + v1[1] * v1[1]) + (v1[2] * v1[2] + v1[3] * v1[3]);
                    if (xb) { u32x4 w; w.x = cvt_pk_bf16(v0[0], v0[1]); w.y = cvt_pk_bf16(v0[2], v0[3]); w.z = cvt_pk_bf16(v1[0], v1[1]); w.w = cvt_pk_bf16(v1[2], v1[3]); *(u32x4*)(xb + off) = w; }
                }
                sq += __shfl_xor(sq, 16); sq += __shfl_xor(sq, 32);
                if (fq == 0) part[(row - u.pm * BM) * 4 + wc] = sq;
            }
          }
        }
        asm volatile("s_waitcnt lgkmcnt(0)" ::: "memory"); __builtin_amdgcn_s_barrier();
        { const int t_ = (wr * 4 + wc) * 64 + fq * 16 + fr;
          if (t_ < 256) { const f32x4 p = *(LAS const f32x4*)(part + t_ * 4); atomicAdd(ss + u.pm * BM + t_, (p[0] + p[1]) + (p[2] + p[3])); } }
    }
};
struct EpiWin {
    static constexpr bool PERM = true;
    bf16_t* QKVU; bf16_t* UP; const float* ss; float* knorm2; LAS float* kpart;
    mutable int pmc = -1; mutable float rsc[2][4] = {};
    __device__ __forceinline__ void operator()(const f32x4 (&acc)[2][2][4][2], const Unit& u, int wr, int wc, int fr, int fq) const {
        const int row0 = u.pm * BM + wr * 64 + fr, col0 = u.pn * BM + wc * 32 + 8 * fq;
        const float cs = (u.pn < 4) ? QSCALE : 1.0f;
        if (u.pm != pmc) {
            float rsv[2][4];
#pragma unroll
            for (int ai = 0; ai < 2; ++ai)
#pragma unroll
                for (int m = 0; m < 4; ++m) rsv[ai][m] = ss[row0 + ai * HALF + m * 16];
#pragma unroll
            for (int ai = 0; ai < 2; ++ai)
#pragma unroll
                for (int m = 0; m < 4; ++m) rsc[ai][m] = rsqrtf(rsv[ai][m] * (1.0f / DM) + NORM_EPS);
            pmc = u.pm;
        }
#pragma unroll
        for (int ai = 0; ai < 2; ++ai)
#pragma unroll
            for (int m = 0; m < 4; ++m) {
                const int row = row0 + ai * HALF + m * 16;
                const float rs = rsc[ai][m] * cs;
#pragma unroll
                for (int bj = 0; bj < 2; ++bj) {
                    const f32x4 v0 = acc[ai][bj][m][0] * rs, v1 = acc[ai][bj][m][1] * rs;
                    u32x4 w; w.x = cvt_pk_bf16(v0[0], v0[1]); w.y = cvt_pk_bf16(v0[2], v0[3]); w.z = cvt_pk_bf16(v1[0], v1[1]); w.w = cvt_pk_bf16(v1[2], v1[3]);
                    const int col = col0 + bj * HALF;
                    if (u.pn >= 4 && u.pn < 8) {
                        float sq = (v0[0] * v0[0] + v0[1] * v0[1]) + (v0[2] * v0[2] + v0[3] * v0[3]) + (v1[0] * v1[0] + v1[1] * v1[1]) + (v1[2] * v1[2] + v1[3] * v1[3]);
                        sq += __shfl_xor(sq, 16); sq += __shfl_xor(sq, 32);
                        if (fq == 0) kpart[((row - u.pm * BM) * 4 + 2 * bj + (wc >> 1)) * 2 + (wc & 1)] = sq;
                    }
                    if (u.pn < 12) *(u32x4*)(QKVU + (size_t)row * DIN + col) = w;
                    else { const int cu = col - 3072, g = cu >> 4, ch = cu & 15, b = row >> 12, t = row & 4095;
                           *(u32x4*)(UP + ((size_t)(b * NGRP + g) * SEQ + t) * HGC + ch) = w; }
                }
            }
        if (u.pn >= 4 && u.pn < 8) {
            asm volatile("s_waitcnt lgkmcnt(0)" ::: "memory"); __builtin_amdgcn_s_barrier();
            const int t_ = (wr * 4 + wc) * 64 + fq * 16 + fr, rowb = u.pm * BM;
#pragma unroll
            for (int i = 0; i < 2; ++i) { const int idx = t_ + 512 * i, hcl = idx >> 8, rl = idx & 255;
                const f32x2 p = *(LAS const f32x2*)(kpart + (rl * 4 + hcl) * 2);
                atomicAdd(knorm2 + (size_t)(((rowb + rl) >> 12) * 16 + 4 * (u.pn - 4) + hcl) * SEQ + ((rowb + rl) & 4095), p[0] + p[1]); }
        }
    }
};
struct EpiGlu {
    static constexpr bool PERM = true;
    bf16_t* QKVU; const float* bias;
    __device__ __forceinline__ void operator()(const f32x4 (&acc)[2][2][4][2], const Unit& u, int wr, int wc, int fr, int fq) const {
        const int row0 = u.pm * BM + wr * 64 + fr, col0 = u.pn * BM + wc * 32 + 8 * fq;
        f32x4 bv[2][2];
#pragma unroll
        for (int bj = 0; bj < 2; ++bj) { bv[bj][0] = *(const f32x4*)(bias + col0 + bj * HALF); bv[bj][1] = *(const f32x4*)(bias + col0 + bj * HALF + 4); }
#pragma unroll
        for (int ai = 0; ai < 2; ++ai) {
          u32x4 gwv[4][2];
#pragma unroll
            for (int m = 0; m < 4; ++m)
#pragma unroll
                for (int bj = 0; bj < 2; ++bj) gwv[m][bj] = *(const u32x4*)(QKVU + (size_t)(row0 + ai * HALF + m * 16) * DIN + 3072 + col0 + bj * HALF);
#pragma unroll
            for (int m = 0; m < 4; ++m) {
                const int row = row0 + ai * HALF + m * 16;
#pragma unroll
                for (int bj = 0; bj < 2; ++bj) {
                    const int col = col0 + bj * HALF;
                    const u32x4 gw = gwv[m][bj];
                    const f32x4 b0 = bv[bj][0], b1 = bv[bj][1];
                    float o[8];
#pragma unroll
                    for (int j = 0; j < 4; ++j) {
                        const unsigned gword0 = gw[j >> 1], gword1 = gw[2 + (j >> 1)];
                        const float g0 = (j & 1) ? __uint_as_float(gword0 & 0xffff0000u) : __uint_as_float(gword0 << 16);
                        const float g1 = (j & 1) ? __uint_as_float(gword1 & 0xffff0000u) : __uint_as_float(gword1 << 16);
                        const float z0 = acc[ai][bj][m][0][j] + b0[j], z1 = acc[ai][bj][m][1][j] + b1[j];
                        o[j] = g0 * __builtin_amdgcn_rcpf(1.0f + __expf(-z0)); o[4 + j] = g1 * __builtin_amdgcn_rcpf(1.0f + __expf(-z1));
                    }
                    u32x4 w; w.x = cvt_pk_bf16(o[0], o[1]); w.y = cvt_pk_bf16(o[2], o[3]); w.z = cvt_pk_bf16(o[4], o[5]); w.w = cvt_pk_bf16(o[6], o[7]);
                    *(u32x4*)(QKVU + (size_t)row * DIN + 1024 + col) = w;
                }
            }
        }
    }
};

struct EpiResidNorm {
    static constexpr bool PERM = true;
    const float* base; float* out; float* ss; unsigned* cnt; const float* gain; float alpha; LAS float* part;
    __device__ __forceinline__ void operator()(f32x4 (&acc)[2][2][4][2], const Unit& u, int wr, int wc, int fr, int fq) const {
        const int row0 = u.pm * BM + wr * 64 + fr, col0 = u.pn * BM + wc * 32 + 8 * fq;
#pragma unroll
        for (int ai = 0; ai < 2; ++ai) {
#pragma unroll
          for (int mh = 0; mh < 2; ++mh) {
          f32x4 bb[2][2][2];
#pragma unroll
          for (int m2 = 0; m2 < 2; ++m2)
#pragma unroll
            for (int bj = 0; bj < 2; ++bj) { const size_t off = (size_t)(row0 + ai * HALF + (2 * mh + m2) * 16) * DM + col0 + bj * HALF;
                bb[m2][bj][0] = *(const f32x4*)(base + off); bb[m2][bj][1] = *(const f32x4*)(base + off + 4); }
#pragma unroll
            for (int m2 = 0; m2 < 2; ++m2) { const int m = 2 * mh + m2;
                const int row = row0 + ai * HALF + m * 16; float sq = 0.f;
#pragma unroll
                for (int bj = 0; bj < 2; ++bj) {
                    const f32x4 v0 = bb[m2][bj][0] + acc[ai][bj][m][0] * alpha, v1 = bb[m2][bj][1] + acc[ai][bj][m][1] * alpha;
                    acc[ai][bj][m][0] = v0; acc[ai][bj][m][1] = v1;
                    sq += (v0[0] * v0[0] + v0[1] * v0[1]) + (v0[2] * v0[2] + v0[3] * v0[3]) + (v1[0] * v1[0] + v1[1] * v1[1]) + (v1[2] * v1[2] + v1[3] * v1[3]);
                }
                sq += __shfl_xor(sq, 16); sq += __shfl_xor(sq, 32);
                if (fq == 0) part[(row - u.pm * BM) * 4 + wc] = sq;
            }
          }
        }
        f32x4 gv[2][2];
#pragma unroll
        for (int bj = 0; bj < 2; ++bj) { gv[bj][0] = *(const f32x4*)(gain + col0 + bj * HALF); gv[bj][1] = *(const f32x4*)(gain + col0 + bj * HALF + 4); }
        asm volatile("s_waitcnt lgkmcnt(0)" ::: "memory"); __builtin_amdgcn_s_barrier();
        { const int t_ = (wr * 4 + wc) * 64 + fq * 16 + fr;
          if (t_ < 256) { const f32x4 p = *(LAS const f32x4*)(part + t_ * 4); atomicAdd(ss + u.pm * BM + t_, (p[0] + p[1]) + (p[2] + p[3])); } }
        asm volatile("s_waitcnt vmcnt(0)" ::: "memory");
        __builtin_amdgcn_s_barrier();
        if (wr == 0 && wc == 0) {
            unsigned* c = cnt + 64 * u.pm;
            __builtin_amdgcn_fence(__ATOMIC_RELEASE, "agent");
            asm volatile("s_waitcnt vmcnt(0)" ::: "memory");
            if (fr == 0 && fq == 0) (void)__hip_atomic_fetch_add(c, 1u, __ATOMIC_RELAXED, __HIP_MEMORY_SCOPE_AGENT);
            unsigned sp = 0;
            while (__hip_atomic_load(c, __ATOMIC_RELAXED, __HIP_MEMORY_SCOPE_AGENT) < 8u) { __builtin_amdgcn_s_sleep(8); if (++sp > (1u << 21)) break; }
            __builtin_amdgcn_fence(__ATOMIC_ACQUIRE, "agent");
            asm volatile("s_waitcnt vmcnt(0)" ::: "memory");
        }
        __builtin_amdgcn_s_barrier();
        float rsv[2][4];
#pragma unroll
        for (int ai = 0; ai < 2; ++ai)
#pragma unroll
            for (int m = 0; m < 4; ++m) rsv[ai][m] = __hip_atomic_load(ss + row0 + ai * HALF + m * 16, __ATOMIC_RELAXED, __HIP_MEMORY_SCOPE_AGENT);
#pragma unroll
        for (int ai = 0; ai < 2; ++ai)
#pragma unroll
            for (int m = 0; m < 4; ++m) { const float rs = rsqrtf(rsv[ai][m] * (1.0f / DM) + NORM_EPS);
#pragma unroll
                for (int bj = 0; bj < 2; ++bj) { const size_t off = (size_t)(row0 + ai * HALF + m * 16) * DM + col0 + bj * HALF;
                    *(f32x4*)(out + off) = acc[ai][bj][m][0] * rs * gv[bj][0]; *(f32x4*)(out + off + 4) = acc[ai][bj][m][1] * rs * gv[bj][1]; } }
    }
};
struct FusedOrder {
    int c;
    __host__ __device__ bool next(int i, Unit& u) const { if (i >= 2) return false; u.pm = 32 * i + 4 * (c & 7) + (c >> 6); u.pn = (c >> 3) & 7; return true; }
};

template <class Epi, class Sched, bool ALIGN_EPI = true, bool SP2 = true>
__device__ __forceinline__ void gemm_phase(LAS unsigned char* lds, const Gemm g, const Sched& S, const Epi& E) {
    int tid = threadIdx.x; asm volatile("" : "+v"(tid));
    const int wid = __builtin_amdgcn_readfirstlane(tid >> 6), lane = tid & 63, wr = wid >> 2, wc = wid & 3, fr = lane & 15, fq = lane >> 4;
    const int K = g.K, nt = K / BK;
    unsigned voffA[2], voffB[2];
#pragma unroll
    for (int i = 0; i < 2; ++i) { int R, C; stage_rc(tid * 16 + i * 8192, R, C); const int Rb = Epi::PERM ? ((R & ~31) + perm32(R & 31)) : R;
        voffA[i] = (unsigned)(R * g.lda + C) * 2u; voffB[i] = (unsigned)(Rb * g.ldb + C) * 2u; }
    const size_t kstep = (size_t)(BK * 2);
    const size_t hA = (size_t)HALF * g.lda * 2, hB = (size_t)HALF * g.ldb * 2;
    const size_t tA = 2 * hA, tB = 2 * hB;
    const unsigned ldsw = (unsigned)wid * 1024u;
    const int aoff = lds_byte(wr * 64 + fr, fq * 8), boff = lds_byte(wc * 32 + fr, fq * 8);
#define PG8_SA(b, h) (((b) * 2 + (h)) * HTB)
#define PG8_SB(b, h) ((4 + (b) * 2 + (h)) * HTB)
#define PG8_STAGE(bufoff, gbase, voff) do { _Pragma("unroll") for (int _i = 0; _i < 2; ++_i) \
        __builtin_amdgcn_global_load_lds((const unsigned*)((const char*)(gbase) + (voff)[_i]), (LAS unsigned*)(lds + (bufoff) + ldsw + _i * 8192), 16, 0, 0); } while (0)
#define PG8_LDA(dst, b, h) do { _Pragma("unroll") for (int m = 0; m < 4; ++m) _Pragma("unroll") for (int k = 0; k < 2; ++k) dst[m][k] = *(const LAS bf16x8*)(lds + PG8_SA(b, h) + aoff + m * 2048 + k * 1024); } while (0)
#define PG8_LDB(dst, b, h) do { _Pragma("unroll") for (int n = 0; n < 2; ++n) _Pragma("unroll") for (int k = 0; k < 2; ++k) dst[n][k] = *(const LAS bf16x8*)(lds + PG8_SB(b, h) + boff + n * 2048 + k * 1024); } while (0)
#define PG8_MMA(ai, bj, At, Bt) do { __builtin_amdgcn_s_setprio(1); _Pragma("unroll") for (int m = 0; m < 4; ++m) _Pragma("unroll") for (int n = 0; n < 2; ++n) _Pragma("unroll") for (int k = 0; k < 2; ++k) \
        acc[ai][bj][m][n] = __builtin_amdgcn_mfma_f32_16x16x32_bf16(Bt[n][k], At[m][k], acc[ai][bj][m][n], 0, 0, 0); __builtin_amdgcn_s_setprio(0); } while (0)
#define PG8_WAIT_V(n) asm volatile("s_waitcnt vmcnt(" #n ")" ::: "memory")
#define PG8_WAIT_L(n) asm volatile("s_waitcnt lgkmcnt(" #n ")" ::: "memory")
#define PG8_BAR __builtin_amdgcn_s_barrier()
#define PG8_SCHED __builtin_amdgcn_sched_barrier(0)
    Unit cur, nxt; int ui = 0;
    if (!S.next(0, cur)) return;
    f32x4 acc[2][2][4][2];
#pragma unroll
    for (int a = 0; a < 2; ++a)
#pragma unroll
        for (int b = 0; b < 2; ++b)
#pragma unroll
            for (int m = 0; m < 4; ++m)
#pragma unroll
                for (int n = 0; n < 2; ++n) acc[a][b][m][n] = (f32x4){0.f, 0.f, 0.f, 0.f};
    bf16x8 At[4][2], B0[2][2], B1[2][2];
    const char* cA = (const char*)g.A + (size_t)cur.pm * tA; const char* cB = (const char*)g.Bt + (size_t)cur.pn * tB;
    if constexpr (SP2) {
        PG8_STAGE(PG8_SB(0, 0), cB, voffB); PG8_STAGE(PG8_SB(0, 1), cB + hB, voffB); PG8_STAGE(PG8_SA(0, 0), cA, voffA); PG8_STAGE(PG8_SA(0, 1), cA + hA, voffA);
        if (wr == 1) PG8_BAR;
        PG8_WAIT_V(2); PG8_BAR;
        PG8_STAGE(PG8_SB(1, 0), cB + kstep, voffB); PG8_STAGE(PG8_SA(1, 0), cA + kstep, voffA); PG8_STAGE(PG8_SB(1, 1), cB + hB + kstep, voffB);
        PG8_WAIT_V(6); PG8_BAR;
    } else {
        PG8_STAGE(PG8_SB(0, 0), cB, voffB); PG8_STAGE(PG8_SA(0, 0), cA, voffA); PG8_STAGE(PG8_SB(0, 1), cB + hB, voffB); PG8_STAGE(PG8_SA(0, 1), cA + hA, voffA);
        if (wr == 1) PG8_BAR;
        PG8_WAIT_V(4); PG8_BAR;
        PG8_STAGE(PG8_SB(1, 0), cB + kstep, voffB); PG8_STAGE(PG8_SA(1, 0), cA + kstep, voffA); PG8_STAGE(PG8_SB(1, 1), cB + hB + kstep, voffB);
        PG8_WAIT_V(6); PG8_BAR;
    }
    for (;;) {
        const bool has_next = S.next(ui + 1, nxt);
        const char* nA = has_next ? (const char*)g.A + (size_t)nxt.pm * tA : cA; const char* nB = has_next ? (const char*)g.Bt + (size_t)nxt.pn * tB : cB;
        for (int t = 0; t < nt; t += 2) {
            const bool last = (t == nt - 2);
            const char* a1 = cA + (size_t)(t + 1) * kstep;
            const char* a2 = last ? nA : cA + (size_t)(t + 2) * kstep; const char* b2 = last ? nB : cB + (size_t)(t + 2) * kstep;
            const char* a3 = a2 + kstep; const char* b3 = b2 + kstep;
            if constexpr (SP2) {
            PG8_LDB(B0, 0, 0); PG8_LDB(B1, 0, 1); PG8_SCHED; PG8_LDA(At, 0, 0); PG8_STAGE(PG8_SA(1, 1), a1 + hA, voffA);
            PG8_WAIT_V(8); PG8_WAIT_L(0); PG8_BAR; PG8_MMA(0, 0, At, B0); PG8_MMA(0, 1, At, B1); PG8_BAR; PG8_SCHED;
            PG8_LDA(At, 0, 1); PG8_STAGE(PG8_SB(0, 0), b2, voffB); PG8_STAGE(PG8_SB(0, 1), b2 + hB, voffB); PG8_STAGE(PG8_SA(0, 0), a2, voffA);
            PG8_WAIT_V(8); PG8_WAIT_L(0); PG8_BAR; PG8_MMA(1, 0, At, B0); PG8_MMA(1, 1, At, B1); PG8_BAR; PG8_SCHED;
            PG8_LDB(B0, 1, 0); PG8_LDB(B1, 1, 1); PG8_SCHED; PG8_LDA(At, 1, 0); PG8_STAGE(PG8_SA(0, 1), a2 + hA, voffA);
            PG8_WAIT_V(8); PG8_WAIT_L(0); PG8_BAR; PG8_MMA(0, 0, At, B0); PG8_MMA(0, 1, At, B1); PG8_BAR; PG8_SCHED;
            PG8_LDA(At, 1, 1); PG8_STAGE(PG8_SB(1, 0), b3, voffB); PG8_STAGE(PG8_SB(1, 1), b3 + hB, voffB); PG8_STAGE(PG8_SA(1, 0), a3, voffA);
            PG8_WAIT_V(8); PG8_WAIT_L(0); PG8_BAR; PG8_MMA(1, 0, At, B0); PG8_MMA(1, 1, At, B1); PG8_BAR; PG8_SCHED;
            } else {
            PG8_LDB(B0, 0, 0); PG8_SCHED; PG8_LDA(At, 0, 0); PG8_STAGE(PG8_SA(1, 1), a1 + hA, voffA);
            PG8_WAIT_L(8); PG8_BAR; PG8_WAIT_L(0); PG8_MMA(0, 0, At, B0); PG8_BAR; PG8_SCHED;
            PG8_LDB(B1, 0, 1); PG8_STAGE(PG8_SB(0, 0), b2, voffB);
            PG8_BAR; PG8_WAIT_L(0); PG8_MMA(0, 1, At, B1); PG8_BAR;
            PG8_LDA(At, 0, 1); PG8_STAGE(PG8_SA(0, 0), a2, voffA);
            PG8_BAR; PG8_WAIT_L(0); PG8_MMA(1, 0, At, B0); PG8_BAR; PG8_SCHED;
            PG8_STAGE(PG8_SB(0, 1), b2 + hB, voffB);
            PG8_WAIT_V(6); PG8_BAR; PG8_MMA(1, 1, At, B1); PG8_BAR;
            PG8_LDB(B0, 1, 0); PG8_SCHED; PG8_LDA(At, 1, 0); PG8_STAGE(PG8_SA(0, 1), a2 + hA, voffA);
            PG8_WAIT_L(8); PG8_BAR; PG8_WAIT_L(0); PG8_MMA(0, 0, At, B0); PG8_BAR; PG8_SCHED;
            PG8_LDB(B1, 1, 1); PG8_STAGE(PG8_SB(1, 0), b3, voffB);
            PG8_BAR; PG8_WAIT_L(0); PG8_MMA(0, 1, At, B1); PG8_BAR;
            PG8_LDA(At, 1, 1); PG8_STAGE(PG8_SA(1, 0), a3, voffA);
            PG8_BAR; PG8_WAIT_L(0); PG8_MMA(1, 0, At, B0); PG8_BAR; PG8_SCHED;
            PG8_STAGE(PG8_SB(1, 1), b3 + hB, voffB);
            PG8_WAIT_V(6); PG8_BAR; PG8_MMA(1, 1, At, B1); PG8_BAR;
            }
        }
        if constexpr (ALIGN_EPI) { if (wr == 0) PG8_BAR; }
        E(acc, cur, wr, wc, fr, fq);
        if (!has_next) break;
#pragma unroll
        for (int a = 0; a < 2; ++a)
#pragma unroll
            for (int b = 0; b < 2; ++b)
#pragma unroll
                for (int m = 0; m < 4; ++m)
#pragma unroll
                    for (int n = 0; n < 2; ++n) acc[a][b][m][n] = (f32x4){0.f, 0.f, 0.f, 0.f};
        cur = nxt; cA = nA; cB = nB; ++ui;
        if constexpr (ALIGN_EPI) { if (wr == 1) PG8_BAR; }
    }
    PG8_WAIT_V(0);
    if constexpr (!ALIGN_EPI) { if (wr == 0) PG8_BAR; }
    PG8_BAR;
#undef PG8_SA
#undef PG8_SB
#undef PG8_STAGE
#undef PG8_LDA
#undef PG8_LDB
#undef PG8_MMA
#undef PG8_WAIT_V
#undef PG8_WAIT_L
#undef PG8_BAR
#undef PG8_SCHED
}
}

constexpr size_t MiB = 1u << 20;
constexpr size_t WS_SS1 = 0, WS_SS2 = 65536, WS_SS3 = 131072, WS_A16 = 262144, WS_BAR = 524288, WS_PCNT = 524288 + 16384;
constexpr size_t WS_WGU1 = 1 * MiB, WS_WD1 = 45 * MiB, WS_WIN = 67 * MiB, WS_WGLU = 83 * MiB, WS_WOUT = 85 * MiB, WS_WGU2 = 93 * MiB, WS_WD2 = 137 * MiB;
constexpr size_t WS_TQ = 159 * MiB, WS_PM = 171 * MiB, WS_XN = 175 * MiB, WS_ACT = 239 * MiB, WS_KN = 415 * MiB, WS_END = 416 * MiB;
constexpr size_t WS_QKVU = WS_ACT, WS_UP = WS_ACT + 128 * MiB;
constexpr int LDS_BYTES = 131072 + 16384;

struct Args { const float* in[28]; float* out; unsigned char* ws; int ph_lo, ph_hi; };

__device__ __forceinline__ int drow_map(int n, int mode) { return mode == 0 ? n : ((n >> 7) * 256 + (n & 127) + (mode == 2 ? 128 : 0)); }
__device__ __forceinline__ void tr_item(const float* __restrict__ W, int K, int N, bf16_t* WT, const float* __restrict__ ksc, int mode, LAS float* scr, int item, int lane) {
    const int nblk = N / 32, kb = item / nblk, nb = item % nblk, k0 = 64 * kb, n0 = 32 * nb;
    const int r8 = lane >> 3, c4 = lane & 7;
    f32x4 v[8];
#pragma unroll
    for (int i = 0; i < 8; ++i) v[i] = *(const f32x4*)(W + (size_t)(k0 + 8 * i + r8) * N + n0 + 4 * c4);
    if (ksc) {
#pragma unroll
        for (int i = 0; i < 8; ++i) v[i] = v[i] * ksc[k0 + 8 * i + r8];
    }
#pragma unroll
    for (int i = 0; i < 8; ++i) { LAS float* d = scr + (8 * i + r8) * 33 + 4 * c4; d[0] = v[i][0]; d[1] = v[i][1]; d[2] = v[i][2]; d[3] = v[i][3]; }
    asm volatile("s_waitcnt lgkmcnt(0)" ::: "memory");
    const int c = lane & 7;
#pragma unroll
    for (int j = 0; j < 4; ++j) { const int n = (lane >> 3) + 8 * j; const LAS float* s = scr + (8 * c) * 33 + n;
        u32x4 o; o.x = cvt_pk_bf16(s[0 * 33], s[1 * 33]); o.y = cvt_pk_bf16(s[2 * 33], s[3 * 33]); o.z = cvt_pk_bf16(s[4 * 33], s[5 * 33]); o.w = cvt_pk_bf16(s[6 * 33], s[7 * 33]);
        *(u32x4*)(WT + (size_t)drow_map(n0 + n, mode) * K + k0 + 8 * c) = o; }
    asm volatile("s_waitcnt lgkmcnt(0)" ::: "memory");
}

__device__ __forceinline__ int crow(int r, int hi) { return (r & 3) + 8 * (r >> 2) + 4 * hi; }
__device__ __forceinline__ s16x4 tr_read(LAS const char* p) {
    typedef short v4i16_t __attribute__((ext_vector_type(4)));
    return __builtin_bit_cast(s16x4, __builtin_amdgcn_ds_read_tr16_b64_v4i16((LAS v4i16_t*)p));
}
__device__ __forceinline__ void attn_unit(int b, int h, int qb, const bf16_t* QKVU, bf16_t* Obuf, int ldo, const float* __restrict__ knorm2, LAS unsigned char* lds, float lam, const float* __restrict__ subln_g) {
    const int tid = threadIdx.x, lane = tid & 63, wid = __builtin_amdgcn_readfirstlane(tid >> 6), comp = wid >> 2, qw = wid & 3, r32 = lane & 31, hi = lane >> 5;
    const size_t rowbase = (size_t)b * SEQ;
    const int q0 = qb * 128, qpos = q0 + 32 * qw + r32, qmin = q0 + 32 * qw;
    const bf16_t* Qp = QKVU + (rowbase + qpos) * DIN + h * 128 + comp * 64;
    bf16x8 qr[4];
#pragma unroll
    for (int d0 = 0; d0 < 4; ++d0) qr[d0] = *(const bf16x8*)(Qp + d0 * 16 + hi * 8);
    const float slope2 = exp2f(-(float)(h + 1)) * LOG2E;
    const int NT = 2 * qb + 2;
    const bf16_t* Kg = QKVU + rowbase * DIN + 1024 + h * 128;
    const bf16_t* Vg = QKVU + rowbase * DIN + 2048 + h * 128;
    const int krow = 8 * wid + (lane >> 3), kpc = lane & 7, kchk = kpc ^ ((krow >> 1) & 7);
    const int vrw0 = 4 * wid + (lane >> 4), vrw1 = vrw0 + 32, vpc = lane & 15;
    const int vchk0 = vpc ^ (((vrw0 & 3) << 2) | ((vrw0 >> 2) & 3)), vchk1 = vpc ^ (((vrw1 & 3) << 2) | ((vrw1 >> 2) & 3));
    const bf16_t* ksrc = Kg + (size_t)krow * DIN + kchk * 8;
    const bf16_t* vsrc0 = Vg + (size_t)vrw0 * DIN + vchk0 * 8;
    const bf16_t* vsrc1 = Vg + (size_t)vrw1 * DIN + vchk1 * 8;
#define ATT_DMA(t, buf) do { const size_t go_ = (size_t)(t) * 64 * DIN; LAS unsigned char* sb_ = lds + ((buf) & 3) * 32768 + wid * 1024; \
        __builtin_amdgcn_global_load_lds((const unsigned*)(ksrc + go_), (LAS unsigned*)(sb_), 16, 0, 0); \
        __builtin_amdgcn_global_load_lds((const unsigned*)(ksrc + go_ + 64), (LAS unsigned*)(sb_ + 8192), 16, 0, 0); \
        __builtin_amdgcn_global_load_lds((const unsigned*)(vsrc0 + go_), (LAS unsigned*)(sb_ + 16384), 16, 0, 0); \
        __builtin_amdgcn_global_load_lds((const unsigned*)(vsrc1 + go_), (LAS unsigned*)(sb_ + 24576), 16, 0, 0); } while (0)
    LAS float* red = (LAS float*)(lds + 131072 + 128);
    LAS unsigned* actf = (LAS unsigned*)(lds + 131072 + 256);
    { const float* kn = knorm2 + (size_t)(b * 16 + 2 * h + comp) * SEQ; const int tq = tid & 255; float mx = 0.f;
      f32x4 knv[4];
#pragma unroll
      for (int j = 0; j < 4; ++j) knv[j] = *(const f32x4*)(kn + (j * 256 + tq) * 4);
      ATT_DMA(NT - 1, (NT - 1) & 3); ATT_DMA(NT >= 2 ? NT - 2 : 0, (NT - 2) & 3); ATT_DMA(NT >= 3 ? NT - 3 : 0, (NT - 3) & 3);
#pragma unroll
      for (int j = 0; j < 4; ++j) { const f32x4 v = knv[j]; mx = fmaxf(fmaxf(mx, fmaxf(v[0], v[1])), fmaxf(v[2], v[3])); }
#pragma unroll
      for (int o = 1; o < 64; o <<= 1) mx = fmaxf(mx, __shfl_xor(mx, o));
      if (lane == 0) red[wid] = mx;
      if (tid < 64) actf[tid] = 0u; }
    int vaddr[4][2];
    { const int i16 = lane & 15, q4 = i16 >> 2, p4 = i16 & 3, blk = (lane >> 4) & 1;
#pragma unroll
      for (int dblk = 0; dblk < 4; ++dblk)
#pragma unroll
        for (int ih = 0; ih < 2; ++ih) { const int row = 4 * hi + q4 + 8 * ih, ch = 4 * dblk + 2 * blk + (p4 >> 1), sw = ((row & 3) << 2) | ((row >> 2) & 3);
            vaddr[dblk][ih] = 16384 + row * 256 + ((ch ^ sw) << 4) + 8 * (p4 & 1); } }
    const int kaoff = r32 * 128, ksw = (r32 >> 1) & 7;
    f32x16 o[4];
#pragma unroll
    for (int d = 0; d < 4; ++d)
#pragma unroll
        for (int r = 0; r < 16; ++r) o[d][r] = 0.f;
    float qn = 0.f;
#pragma unroll
    for (int d0 = 0; d0 < 4; ++d0)
#pragma unroll
        for (int j = 0; j < 8; ++j) { const float v = __uint_as_float(((unsigned)(unsigned short)qr[d0][j]) << 16); qn += v * v; }
    qn += __shfl_xor(qn, 32);
    asm volatile("s_waitcnt vmcnt(8) lgkmcnt(0)" ::: "memory");
    __builtin_amdgcn_s_barrier();
    const float kmax = sqrtf(fmaxf(fmaxf(red[4 * comp], red[4 * comp + 1]), fmaxf(red[4 * comp + 2], red[4 * comp + 3])));
    const float bq = sqrtf(qn) * kmax * 1.02f + 1.0f;
    float mrun = 0.f, lrun = 0.f, dq = slope2 * (float)(4 * hi - qpos);
    bool first = true, active = true;
    for (int t = NT - 1; t >= 0; --t) {
        const int buf = t & 3;
        ATT_DMA(t >= 3 ? t - 3 : 0, (t - 3) & 3);
        const int kv0 = t * 64;
        if (active && kv0 <= qmin + 31) {
            const int dmin = qmin - (kv0 + 63);
            if (!first && dmin > 0 && __all((bq - mrun) < slope2 * (float)dmin - 150.0f)) {
                active = false;
            } else {
            LAS const unsigned char* Kb = lds + buf * 32768 + comp * 8192;
            LAS const unsigned char* Sb = lds + buf * 32768;
            f32x16 p0, p1;
            const float dqt = dq + slope2 * (float)kv0;
#pragma unroll
            for (int r = 0; r < 16; ++r) { p0[r] = fmaf(slope2, (float)((r & 3) + 8 * (r >> 2)), dqt); p1[r] = fmaf(slope2, (float)(32 + (r & 3) + 8 * (r >> 2)), dqt); }
            bf16x8 k0f[4], k1f[4];
#pragma unroll
            for (int d0 = 0; d0 < 4; ++d0) {
                const int csw = ((2 * d0 + hi) ^ ksw) << 4;
                k0f[d0] = *(LAS const bf16x8*)(Kb + kaoff + csw);
                k1f[d0] = *(LAS const bf16x8*)(Kb + 4096 + kaoff + csw);
            }
            __builtin_amdgcn_sched_barrier(0);
#pragma unroll
            for (int d0 = 0; d0 < 4; ++d0) {
                p0 = __builtin_amdgcn_mfma_f32_32x32x16_bf16(k0f[d0], qr[d0], p0, 0, 0, 0);
                p1 = __builtin_amdgcn_mfma_f32_32x32x16_bf16(k1f[d0], qr[d0], p1, 0, 0, 0);
            }
            bf16x8 va[4], vb[4];
#define ATT_VREAD(dst, s_) do { _Pragma("unroll") for (int dblk = 0; dblk < 4; ++dblk) { \
                const s16x4 lo_ = tr_read((LAS const char*)(Sb + vaddr[dblk][0] + (s_) * 4096)); const s16x4 hv_ = tr_read((LAS const char*)(Sb + vaddr[dblk][1] + (s_) * 4096)); \
                dst[dblk] = (bf16x8){lo_[0], lo_[1], lo_[2], lo_[3], hv_[0], hv_[1], hv_[2], hv_[3]}; } } while (0)
#define ATT_PV(src, s_) do { _Pragma("unroll") for (int dblk = 0; dblk < 4; ++dblk) o[dblk] = __builtin_amdgcn_mfma_f32_32x32x16_bf16(src[dblk], pf[s_], o[dblk], 0, 0, 0); } while (0)
            ATT_VREAD(va, 0); ATT_VREAD(vb, 1);
            __builtin_amdgcn_sched_barrier(0);
            if (kv0 + 63 > qmin) {
#pragma unroll
                for (int r = 0; r < 16; ++r) { const int kv = kv0 + crow(r, hi); if (kv > qpos) p0[r] = -INFINITY; if (kv + 32 > qpos) p1[r] = -INFINITY; }
            }
            float x = fmaxf(p0[0], p1[0]);
#pragma unroll
            for (int r = 1; r < 16; ++r) x = fmaxf(fmaxf(x, p0[r]), p1[r]);
            x = fmaxf(x, __shfl_xor(x, 32));
            if (first || __any(x > 0.f)) {
                const float xp = first ? x : fmaxf(x, 0.f);
                mrun += xp; dq -= xp;
                const float alpha = __builtin_amdgcn_exp2f(-xp);
                lrun *= alpha;
#pragma unroll
                for (int r = 0; r < 16; ++r) { p0[r] -= xp; p1[r] -= xp; }
                if (!first) {
#pragma unroll
                    for (int d = 0; d < 4; ++d)
#pragma unroll
                        for (int r = 0; r < 16; ++r) o[d][r] *= alpha;
                }
                first = false;
            }
            float sum = 0.f;
#pragma unroll
            for (int r = 0; r < 16; ++r) { p0[r] = __builtin_amdgcn_exp2f(p0[r]); p1[r] = __builtin_amdgcn_exp2f(p1[r]); sum += p0[r] + p1[r]; }
            lrun += sum;
            bf16x8 pf[4];
#pragma unroll
            for (int s = 0; s < 4; ++s) {
                u32x4 w;
                if (s < 2) { w.x = cvt_pk_bf16_b(p0[8 * s + 0], p0[8 * s + 1]); w.y = cvt_pk_bf16_b(p0[8 * s + 2], p0[8 * s + 3]); w.z = cvt_pk_bf16_b(p0[8 * s + 4], p0[8 * s + 5]); w.w = cvt_pk_bf16_b(p0[8 * s + 6], p0[8 * s + 7]); }
                else { const int s2 = s - 2; w.x = cvt_pk_bf16_b(p1[8 * s2 + 0], p1[8 * s2 + 1]); w.y = cvt_pk_bf16_b(p1[8 * s2 + 2], p1[8 * s2 + 3]); w.z = cvt_pk_bf16_b(p1[8 * s2 + 4], p1[8 * s2 + 5]); w.w = cvt_pk_bf16_b(p1[8 * s2 + 6], p1[8 * s2 + 7]); }
                pf[s] = __builtin_bit_cast(bf16x8, w);
            }
            __builtin_amdgcn_sched_barrier(0);
            ATT_PV(va, 0); __builtin_amdgcn_sched_barrier(0);
            ATT_VREAD(va, 2); __builtin_amdgcn_sched_barrier(0);
            ATT_PV(vb, 1); __builtin_amdgcn_sched_barrier(0);
            ATT_VREAD(vb, 3); __builtin_amdgcn_sched_barrier(0);
            ATT_PV(va, 2); __builtin_amdgcn_sched_barrier(0);
            ATT_PV(vb, 3);
#undef ATT_VREAD
#undef ATT_PV
            }
        }
        if (active && lane == 0) actf[t] = 1u;
        asm volatile("s_waitcnt vmcnt(8) lgkmcnt(0)" ::: "memory");
        __builtin_amdgcn_s_barrier();
        if (*(volatile LAS unsigned*)(actf + t) == 0u) break;
    }
#undef ATT_DMA
    lrun += __shfl_xor(lrun, 32);
    const float inv = 1.0f / lrun;
    LAS float* X = (LAS float*)lds;
    asm volatile("s_waitcnt vmcnt(0)" ::: "memory");
    __syncthreads();
    if (comp == 1) {
#pragma unroll
        for (int d = 0; d < 4; ++d)
#pragma unroll
            for (int r = 0; r < 16; ++r) X[(32 * d + crow(r, hi)) * 128 + 32 * qw + r32] = o[d][r] * inv;
    }
    __syncthreads();
    if (comp == 0) {
        float ssq = 0.f;
        f32x16 xv[4];
#pragma unroll
        for (int d = 0; d < 4; ++d)
#pragma unroll
            for (int r = 0; r < 16; ++r) xv[d][r] = X[(32 * d + crow(r, hi)) * 128 + 32 * qw + r32];
        __builtin_amdgcn_sched_barrier(0);
#pragma unroll
        for (int d = 0; d < 4; ++d)
#pragma unroll
            for (int r = 0; r < 16; ++r) { const float v = o[d][r] * inv - lam * xv[d][r]; o[d][r] = v; ssq += v * v; }
        ssq += __shfl_xor(ssq, 32);
        const float sc = rsqrtf(ssq * (1.0f / 128.0f) + SUBLN_EPS) * (1.0f - LAMBDA_INIT);
        bf16_t* Op = Obuf + (rowbase + qpos) * (size_t)ldo + h * 128;
        f32x4 g4v[4][4];
#pragma unroll
        for (int d = 0; d < 4; ++d)
#pragma unroll
            for (int rg = 0; rg < 4; ++rg) g4v[d][rg] = *(const f32x4*)(subln_g + 32 * d + 8 * rg + 4 * hi);
#pragma unroll
        for (int d = 0; d < 4; ++d)
#pragma unroll
            for (int rg = 0; rg < 4; ++rg) { const int dd = 32 * d + 8 * rg + 4 * hi; const f32x4 g4 = g4v[d][rg];
                u32x2 w; w.x = cvt_pk_bf16(o[d][4 * rg + 0] * sc * g4[0], o[d][4 * rg + 1] * sc * g4[1]); w.y = cvt_pk_bf16(o[d][4 * rg + 2] * sc * g4[2], o[d][4 * rg + 3] * sc * g4[3]);
                *(u32x2*)(Op + dd) = w; }
    }
    __syncthreads();
}

__device__ __forceinline__ float gelu_tanh(float x) {
    const float z = 0.7978845608028654f * (x + 0.044715f * x * x * x);
    return x * __builtin_amdgcn_rcpf(1.0f + __expf(-2.0f * z));
}
__device__ __forceinline__ void ssm_unit(int b, int g, const bf16_t* __restrict__ UP, const bf16_t* __restrict__ TQ, const bf16_t* __restrict__ PM, const float* __restrict__ A16, bf16_t* QKVU, LAS unsigned char* lds, bool do_store = true) {
    const int tid = threadIdx.x, lane = tid & 63, wid = __builtin_amdgcn_readfirstlane(tid >> 6), r32 = lane & 31, hi = lane >> 5;
    LAS unsigned char* UQ = lds;
    LAS float* XL = (LAS float*)(lds + 33792);
    LAS unsigned char* XI = lds + 66560;
    const bf16_t* Ub = UP + (size_t)(b * NGRP + g) * (SEQ * HGC);
    const bf16_t* TQg = TQ + (size_t)g * 256 * 384;
    const bf16_t* PMg = PM + (size_t)g * 128 * 256;
    const float a16r = A16[(g * NST + lane) * 2], a16i = A16[(g * NST + lane) * 2 + 1];
    const int rb1 = wid >> 2, cb1 = wid & 3;
    bf16x8 tq[16];
    const bf16_t* Tp = TQg + (size_t)(32 * wid + r32) * 384 + 8 * hi;
#pragma unroll
    for (int ks = 0; ks < 16; ++ks) tq[ks] = *(const bf16x8*)(Tp + 16 * ks);
    const bf16_t* Pp = PMg + (size_t)(32 * cb1 + r32) * 256 + 8 * hi;
    float sr = 0.f, si = 0.f;
    for (int qi = 0; qi < 4; ++qi) {
        { u32x4 un[4];
#pragma unroll
          for (int j = 0; j < 4; ++j) un[j] = *(const u32x4*)(Ub + (size_t)qi * 16384 + (size_t)(j * 512 + tid) * 8);
#pragma unroll
          for (int j = 0; j < 4; ++j) { const int idx = j * 512 + tid, row = idx >> 5, cc = idx & 31; *(LAS u32x4*)(UQ + row * 528 + cc * 16) = un[j]; } }
        bf16x8 pm[16];
#pragma unroll
        for (int ks = 0; ks < 16; ++ks) pm[ks] = *(const bf16x8*)(Pp + 16 * ks);
        __syncthreads();
        { f32x16 acc;
#pragma unroll
          for (int r = 0; r < 16; ++r) acc[r] = 0.f;
          LAS const unsigned char* ua = UQ + (32 * rb1 + r32) * 528 + 16 * hi;
          bf16x8 fa[4];
#define SSM_XLD(dst, g_) do { _Pragma("unroll") for (int i_ = 0; i_ < 4; ++i_) dst[i_] = *(LAS const bf16x8*)(ua + 32 * (4 * (g_) + i_)); } while (0)
#define SSM_XMM(src, g_) do { _Pragma("unroll") for (int i_ = 0; i_ < 4; ++i_) acc = __builtin_amdgcn_mfma_f32_32x32x16_bf16(src[i_], pm[4 * (g_) + i_], acc, 0, 0, 0); } while (0)
#pragma unroll
          for (int g4 = 0; g4 < 4; ++g4) { SSM_XLD(fa, g4); __builtin_amdgcn_sched_barrier(0); SSM_XMM(fa, g4); __builtin_amdgcn_sched_barrier(0); }
#undef SSM_XLD
#undef SSM_XMM
#pragma unroll
          for (int r = 0; r < 16; ++r) XL[(32 * rb1 + crow(r, hi)) * 128 + 32 * cb1 + r32] = acc[r]; }
        bf16x8 qf[8];
#pragma unroll
        for (int ks = 0; ks < 8; ++ks) qf[ks] = *(const bf16x8*)(Tp + 256 + 16 * ks);
        __syncthreads();
        if (wid == 0) {
            for (int c0 = 0; c0 < 64; c0 += 8) {
                float xr[8], xi[8];
#pragma unroll
                for (int j = 0; j < 8; ++j) { xr[j] = XL[(c0 + j) * 128 + lane]; xi[j] = XL[(c0 + j) * 128 + 64 + lane]; }
#pragma unroll
                for (int j = 0; j < 8; ++j) {
                    *(LAS unsigned short*)(XI + (c0 + j) * 272 + lane * 2) = (unsigned short)(cvt_pk_bf16(sr, 0.f) & 0xffffu);
                    *(LAS unsigned short*)(XI + (c0 + j) * 272 + 128 + lane * 2) = (unsigned short)(cvt_pk_bf16(si, 0.f) & 0xffffu);
                    const float nr = a16r * sr - a16i * si + xr[j], ni = a16r * si + a16i * sr + xi[j];
                    sr = nr; si = ni;
                }
            }
        }
        __syncthreads();
        { f32x16 acc[2];
#pragma unroll
          for (int rb = 0; rb < 2; ++rb)
#pragma unroll
            for (int r = 0; r < 16; ++r) acc[rb][r] = 0.f;
          LAS const unsigned char* ya = UQ + r32 * 528 + 16 * hi;
          LAS const unsigned char* yx = XI + r32 * 272 + 16 * hi;
          bf16x8 fa[4];
#define SSM_YLD(dst, g_) do { _Pragma("unroll") for (int i_ = 0; i_ < 2; ++i_) _Pragma("unroll") for (int rb = 0; rb < 2; ++rb) { const int ks_ = 2 * (g_) + i_; \
              dst[2 * i_ + rb] = (ks_ < 16) ? *(LAS const bf16x8*)(ya + rb * (32 * 528) + 32 * ks_) : *(LAS const bf16x8*)(yx + rb * (32 * 272) + 32 * (ks_ - 16)); } } while (0)
#define SSM_YMM(src, g_) do { _Pragma("unroll") for (int i_ = 0; i_ < 2; ++i_) _Pragma("unroll") for (int rb = 0; rb < 2; ++rb) { const int ks_ = 2 * (g_) + i_; \
              acc[rb] = __builtin_amdgcn_mfma_f32_32x32x16_bf16(src[2 * i_ + rb], (ks_ < 16) ? tq[ks_ & 15] : qf[ks_ & 7], acc[rb], 0, 0, 0); } } while (0)
#pragma unroll
          for (int g2 = 0; g2 < 12; ++g2) { SSM_YLD(fa, g2); __builtin_amdgcn_sched_barrier(0); SSM_YMM(fa, g2); __builtin_amdgcn_sched_barrier(0); }
#undef SSM_YLD
#undef SSM_YMM
          LAS unsigned short* YS = (LAS unsigned short*)XL;
#pragma unroll
          for (int rb = 0; rb < 2; ++rb)
#pragma unroll
            for (int r = 0; r < 16; ++r) { const int c = 32 * rb + crow(r, hi);
                const float gv = gelu_tanh(acc[rb][r]);
                YS[c * 256 + 32 * wid + r32] = (unsigned short)(cvt_pk_bf16(gv, 0.f) & 0xffffu); } }
        __syncthreads();
        if (do_store) {
#pragma unroll
        for (int j = 0; j < 4; ++j) { const int id = j * 512 + tid, c = id >> 5, pos = id & 31, tau = pos >> 1, h8 = (pos & 1) * 8;
            const u32x4 v = *(LAS const u32x4*)((LAS const unsigned char*)XL + c * 512 + pos * 16);
            *(u32x4*)(QKVU + ((size_t)b * SEQ + (size_t)(64 * qi + c) * 16 + tau) * DIN + 3072 + g * HGC + h8) = v; }
        }
        __syncthreads();
    }
}

#define XB_TMO      128
#define XB_XCNT(j)  (256  + 64 * (j))
#define XB_XSUB(j)  (1280 + 64 * (j))
#define XB_XGEN(j)  (2304 + 64 * (j))
#define XB_TOP      3328
#define XB_TOPGEN   3392
#define XCD_BAR_WORDS 3456
#define XB_SPIN_CAP (1u << 18)
__device__ __forceinline__ unsigned xb_ld(unsigned* p)              { return __hip_atomic_load(p, __ATOMIC_RELAXED, __HIP_MEMORY_SCOPE_AGENT); }
__device__ __forceinline__ unsigned xb_add(unsigned* p, unsigned v) { return __hip_atomic_fetch_add(p, v, __ATOMIC_RELAXED, __HIP_MEMORY_SCOPE_AGENT); }
__device__ __forceinline__ unsigned xb_xcc_id() { return (unsigned)__builtin_amdgcn_s_getreg((3 << 11) | 20) & 0xFu; }
#define XB_SPIN(cond, bar) do { unsigned _sp = 0; while (cond) { __builtin_amdgcn_s_sleep(1); \
    if ((++_sp & 255u) == 0u) { if (xb_ld(&(bar)[XB_TMO])) break; if (_sp > XB_SPIN_CAP) { atomicAdd(&(bar)[XB_TMO], 1u); break; } } } } while (0)
struct XcdBarrier { unsigned* bar; unsigned x; volatile LAS unsigned* st; };
__device__ __forceinline__ XcdBarrier xcd_barrier_post(unsigned* bar, volatile LAS unsigned* st) {
    XcdBarrier b; b.bar = bar; b.x = xb_xcc_id(); b.st = st;
    if (threadIdx.x == 0) (void)xb_add(&bar[XB_XCNT(b.x)], 1u);
    return b;
}
__device__ __forceinline__ void xcd_barrier_complete(unsigned* bar, unsigned x, unsigned& nloc, unsigned& nx) {
    const unsigned G = gridDim.x * gridDim.y * gridDim.z;
    unsigned sum, cnt, mine, sp = 0u;
    for (;;) {
        sum = 0u; cnt = 0u; mine = 0u;
#pragma unroll
        for (unsigned j = 0; j < 16; ++j) { const unsigned c = xb_ld(&bar[XB_XCNT(j)]); sum += c; cnt += (c > 0u) ? 1u : 0u; mine = (j == x) ? c : mine; }
        if (sum == G) break;
        __builtin_amdgcn_s_sleep(1);
        if ((++sp & 255u) == 0u) { if (xb_ld(&bar[XB_TMO])) break; if (sp > XB_SPIN_CAP) { atomicAdd(&bar[XB_TMO], 1u); break; } }
    }
    nloc = mine > 0u ? mine : 1u; nx = cnt > 0u ? cnt : 1u;
}
__device__ __forceinline__ void xcd_barrier(const XcdBarrier& b) {
    asm volatile("s_waitcnt vmcnt(0)" ::: "memory");
    __syncthreads();
    if (threadIdx.x == 0) {
        unsigned* bar = b.bar;
        __builtin_amdgcn_s_waitcnt(0);
        unsigned nloc = b.st[0], nx = b.st[1];
        if (nloc == 0u) { xcd_barrier_complete(bar, b.x, nloc, nx); b.st[0] = nloc; b.st[1] = nx; }
        const unsigned old = xb_add(&bar[XB_XSUB(b.x)], 1u);
        const unsigned gen = old / nloc;
        if (old + 1u == (gen + 1u) * nloc) {
            __builtin_amdgcn_fence(__ATOMIC_RELEASE, "agent");
            asm volatile("s_waitcnt vmcnt(0)" ::: "memory");
            const unsigned og = xb_add(&bar[XB_TOP], 1u);
            const unsigned tg = og / nx;
            if (og + 1u == (tg + 1u) * nx) xb_add(&bar[XB_TOPGEN], 1u);
            else XB_SPIN(xb_ld(&bar[XB_TOPGEN]) == tg, bar);
            __builtin_amdgcn_fence(__ATOMIC_ACQUIRE, "agent");
            xb_add(&bar[XB_XGEN(b.x)], 1u);
            asm volatile("s_waitcnt vmcnt(0)" ::: "memory");
        } else {
            XB_SPIN(xb_ld(&bar[XB_XGEN(b.x)]) == gen, bar);
            __builtin_amdgcn_fence(__ATOMIC_ACQUIRE, "agent");
            asm volatile("s_waitcnt vmcnt(0)" ::: "memory");
        }
    }
    __syncthreads();
}

static __device__ const unsigned att_tab[64] = {173134591u,155831038u,138527485u,2021260023u,1886515958u,1751771893u,1617027836u,1482283764u,3368634095u,3233891822u,3099149549u,2964407276u,2829667815u,2694925542u,2560183269u,120801252u,2425443551u,2290701278u,103960541u,1345277660u,2155961303u,1210996694u,1076713173u,942429652u,808148943u,673865422u,338124237u,321281228u,304441031u,287598022u,4163069125u,4028785604u,469331391u,452029630u,434727869u,88041404u,400651447u,383349686u,71200693u,54357684u,366050223u,37517230u,20674221u,3831212u,540515239u,406229926u,271944613u,255099812u,240827295u,223523742u,206220189u,188916636u,3900365719u,3765621654u,3630877589u,3496133524u,530250639u,512947086u,495643533u,478339980u,968523655u,833781382u,699039109u,564296836u};

__global__ void __launch_bounds__(512, 2) mk_fwd(Args args) {
    extern __shared__ __attribute__((aligned(16))) unsigned char lds_raw[];
    LAS unsigned char* lds = (LAS unsigned char*)lds_raw;
    cg::grid_group grid = cg::this_grid();
    const int tid = threadIdx.x, lane = tid & 63, wave = __builtin_amdgcn_readfirstlane(tid >> 6);
    const int G = gridDim.x, bx = blockIdx.x;
    const int vcu = (G % 8 == 0) ? (bx % 8) * (G / 8) + bx / 8 : bx;
    unsigned char* ws = args.ws;
    const float* x = args.in[0];
    float* out = args.out;
    float* ss1 = (float*)(ws + WS_SS1); float* ss2 = (float*)(ws + WS_SS2); float* ss3 = (float*)(ws + WS_SS3); float* A16 = (float*)(ws + WS_A16);
    bf16_t* Wgu1 = (bf16_t*)(ws + WS_WGU1); bf16_t* Wd1 = (bf16_t*)(ws + WS_WD1); bf16_t* Win = (bf16_t*)(ws + WS_WIN); bf16_t* Wglu = (bf16_t*)(ws + WS_WGLU);
    bf16_t* Wout = (bf16_t*)(ws + WS_WOUT); bf16_t* Wgu2 = (bf16_t*)(ws + WS_WGU2); bf16_t* Wd2 = (bf16_t*)(ws + WS_WD2);
    bf16_t* TQ = (bf16_t*)(ws + WS_TQ); bf16_t* PM = (bf16_t*)(ws + WS_PM); bf16_t* XN = (bf16_t*)(ws + WS_XN); bf16_t* ACT = (bf16_t*)(ws + WS_ACT);
    bf16_t* QKVU = (bf16_t*)(ws + WS_QKVU); bf16_t* UP = (bf16_t*)(ws + WS_UP); float* KN = (float*)(ws + WS_KN);
    const int lo = args.ph_lo, hi_ph = args.ph_hi;
#define IN(k) (lo <= (k) && (k) < hi_ph)
    volatile LAS unsigned* bst = (volatile LAS unsigned*)(lds + 131072 + 64);
    if (tid < 4) bst[tid] = 0u;
    __syncthreads();
    unsigned* barw = (unsigned*)(ws + WS_BAR);
    if (args.ph_lo < 0) grid.sync();
    XcdBarrier xbar = xcd_barrier_post(barw, bst);
#define SEAM(k) do { if (IN(k) && IN((k) + 1)) xcd_barrier(xbar); } while (0)

    if (IN(0)) {
        { LAS float* scr = (LAS float*)(lds + wave * 8448);
          const int gw = vcu * 8 + wave, NGW = G * 8;
          constexpr int I_F = (DM / 64) * (DFF / 32), I_D = (DFF / 64) * (DM / 32), I_IN = (DM / 64) * (DIN / 32), I_GL = (1024 / 64) * (1024 / 32), I_O = (DM / 64) * (DM / 32);
          constexpr int NITEMS = 4 * I_F + 2 * I_D + I_IN + I_GL + I_O;
          for (int it = gw; it < (PROBE == 3 ? 2 : 1) * NITEMS; it += NGW) {
              int r = it % NITEMS;
              if (r < I_F) { tr_item(args.in[2], DM, DFF, Wgu1, nullptr, 1, scr, r, lane); continue; } r -= I_F;
              if (r < I_F) { tr_item(args.in[3], DM, DFF, Wgu1, nullptr, 2, scr, r, lane); continue; } r -= I_F;
              if (r < I_D) { tr_item(args.in[4], DFF, DM, Wd1, nullptr, 0, scr, r, lane); continue; } r -= I_D;
              if (r < I_IN) { tr_item(args.in[6], DM, DIN, Win, args.in[5], 0, scr, r, lane); continue; } r -= I_IN;
              if (r < I_GL) { tr_item(args.in[20], 1024, 1024, Wglu, nullptr, 0, scr, r, lane); continue; } r -= I_GL;
              if (r < I_O) { tr_item(args.in[22], DM, DM, Wout, nullptr, 0, scr, r, lane); continue; } r -= I_O;
              if (r < I_F) { tr_item(args.in[24], DM, DFF, Wgu2, args.in[23], 1, scr, r, lane); continue; } r -= I_F;
              if (r < I_F) { tr_item(args.in[25], DM, DFF, Wgu2, args.in[23], 2, scr, r, lane); continue; } r -= I_F;
              tr_item(args.in[26], DFF, DM, Wd2, nullptr, 0, scr, r, lane);
          }
          const float* g1 = args.in[1];
          f32x4 g1v[8];
#pragma unroll
          for (int j = 0; j < 8; ++j) g1v[j] = *((const f32x4*)g1 + lane + 64 * j);
          for (int m2 = gw; m2 < (PROBE == 8 ? 2 : 1) * MTOK; m2 += NGW) {
              const int m = m2 % MTOK;
              const f32x4* xr = (const f32x4*)(x + (size_t)m * DM) + lane;
              f32x4 v[8]; float s = 0.f;
#pragma unroll
              for (int j = 0; j < 8; ++j) { v[j] = xr[64 * j]; s += (v[j][0] * v[j][0] + v[j][1] * v[j][1]) + (v[j][2] * v[j][2] + v[j][3] * v[j][3]); }
              const float rs = rsqrtf(wave_sum(s) * (1.0f / DM) + NORM_EPS);
              u32x2* o8 = (u32x2*)(XN + (size_t)m * DM) + lane;
#pragma unroll
              for (int j = 0; j < 8; ++j) { const f32x4 gg = g1v[j]; u32x2 w; w.x = cvt_pk_bf16(v[j][0] * rs * gg[0], v[j][1] * rs * gg[1]); w.y = cvt_pk_bf16(v[j][2] * rs * gg[2], v[j][3] * rs * gg[3]); o8[64 * j] = w; }
          }
        }
        for (int i = bx * 512 + tid; i < 3 * MTOK; i += G * 512) ((float*)(ws + WS_SS1))[i] = 0.f;
        for (int i = bx * 512 + tid; i < BATCH * 16 * SEQ; i += G * 512) KN[i] = 0.f;
        __syncthreads();
        if (bx < 256) {
            const int g = bx & 63, part = bx >> 6;
            LAS float* pwr = (LAS float*)lds; LAS float* pwi = pwr + 17 * 64; LAS float* bbr = pwi + 17 * 64; LAS float* bbi = bbr + 1024; LAS float* crr = bbi + 1024; LAS float* cii = crr + 1024; LAS float* Kd = cii + 1024;
            const float* lam_re = args.in[12] + g * NST; const float* lam_im = args.in[13] + g * NST;
            const float dt = expf(args.in[14][g]);
            for (int idx = tid; idx < 17 * 64; idx += 512) { const int d = idx >> 6, p = idx & 63; const float lr = lam_re[p], li = lam_im[p];
                const float mag = expf((float)d * (lr * dt)), ang = (float)d * (li * dt); pwr[idx] = mag * cosf(ang); pwi[idx] = mag * sinf(ang); }
            for (int idx = tid; idx < 1024; idx += 512) { const int p = idx >> 4; const float lr = lam_re[p], li = lam_im[p];
                const float mag = expf(lr * dt), abr = mag * cosf(li * dt), abi = mag * sinf(li * dt), den = lr * lr + li * li;
                const float fr_ = ((abr - 1.0f) * lr + abi * li) / den, fi_ = (abi * lr - (abr - 1.0f) * li) / den;
                const float br = args.in[15][(size_t)g * 1024 + idx], bi = args.in[16][(size_t)g * 1024 + idx];
                bbr[idx] = fr_ * br - fi_ * bi; bbi[idx] = fr_ * bi + fi_ * br;
                crr[idx] = args.in[17][(size_t)g * 1024 + idx]; cii[idx] = args.in[18][(size_t)g * 1024 + idx]; }
            __syncthreads();
            {
              const int d = tid >> 5, h = (tid >> 1) & 15, hb = (tid & 1) * 8; float acc8[8];
#pragma unroll
              for (int j = 0; j < 8; ++j) acc8[j] = 0.f;
              for (int p = 0; p < 64; ++p) { const float cr = crr[h * 64 + p], ci = cii[h * 64 + p], pr = pwr[d * 64 + p], pi = pwi[d * 64 + p];
                  const float er = cr * pr - ci * pi, ei = cr * pi + ci * pr;
                  const f32x4 br0 = *(LAS const f32x4*)(bbr + p * 16 + hb), br1 = *(LAS const f32x4*)(bbr + p * 16 + hb + 4), bi0 = *(LAS const f32x4*)(bbi + p * 16 + hb), bi1 = *(LAS const f32x4*)(bbi + p * 16 + hb + 4);
#pragma unroll
                  for (int j = 0; j < 4; ++j) { acc8[j] += er * br0[j] - ei * bi0[j]; acc8[4 + j] += er * br1[j] - ei * bi1[j]; } }
#pragma unroll
              for (int j = 0; j < 8; ++j) { float a = acc8[j]; if (d == 0 && h == hb + j) a += args.in[19][g * HGC + h]; Kd[d * 256 + h * 16 + hb + j] = a; } }
            __syncthreads();
            bf16_t* TQg = TQ + (size_t)g * 256 * 384; bf16_t* PMg = PM + (size_t)g * 128 * 256;
            for (int ck = tid; ck < 64 * 48; ck += 512) { const int row = 64 * part + ck / 48, c8 = (ck % 48) * 8, tau = row >> 4, h = row & 15; float v[8];
                if (c8 < 256) { const int sg = c8 >> 4, h2 = c8 & 15;
                    if (tau >= sg) { const f32x4 k0 = *(LAS const f32x4*)(Kd + (tau - sg) * 256 + h * 16 + h2), k1 = *(LAS const f32x4*)(Kd + (tau - sg) * 256 + h * 16 + h2 + 4);
#pragma unroll
                        for (int j = 0; j < 4; ++j) { v[j] = k0[j]; v[4 + j] = k1[j]; } }
                    else {
#pragma unroll
                        for (int j = 0; j < 8; ++j) v[j] = 0.f; } }
                else { const bool im = (c8 >= 320); const int p = c8 - (im ? 320 : 256);
                    const f32x4 cr0 = *(LAS const f32x4*)(crr + h * 64 + p), cr1 = *(LAS const f32x4*)(crr + h * 64 + p + 4), ci0 = *(LAS const f32x4*)(cii + h * 64 + p), ci1 = *(LAS const f32x4*)(cii + h * 64 + p + 4);
                    const f32x4 pr0 = *(LAS const f32x4*)(pwr + (tau + 1) * 64 + p), pr1 = *(LAS const f32x4*)(pwr + (tau + 1) * 64 + p + 4), pi0 = *(LAS const f32x4*)(pwi + (tau + 1) * 64 + p), pi1 = *(LAS const f32x4*)(pwi + (tau + 1) * 64 + p + 4);
#pragma unroll
                    for (int j = 0; j < 4; ++j) { v[j] = im ? -(cr0[j] * pi0[j] + ci0[j] * pr0[j]) : (cr0[j] * pr0[j] - ci0[j] * pi0[j]);
                                                  v[4 + j] = im ? -(cr1[j] * pi1[j] + ci1[j] * pr1[j]) : (cr1[j] * pr1[j] - ci1[j] * pi1[j]); } }
                u32x4 w; w.x = cvt_pk_bf16(v[0], v[1]); w.y = cvt_pk_bf16(v[2], v[3]); w.z = cvt_pk_bf16(v[4], v[5]); w.w = cvt_pk_bf16(v[6], v[7]);
                *(u32x4*)(TQg + (size_t)row * 384 + c8) = w; }
            for (int ck = tid; ck < 32 * 32; ck += 512) { const int row = 32 * part + (ck >> 5), c8 = (ck & 31) * 8, sg = c8 >> 4, h2 = c8 & 15, p = row & 63;
                const float pr = pwr[(15 - sg) * 64 + p], pi = pwi[(15 - sg) * 64 + p];
                const f32x4 br0 = *(LAS const f32x4*)(bbr + p * 16 + h2), br1 = *(LAS const f32x4*)(bbr + p * 16 + h2 + 4), bi0 = *(LAS const f32x4*)(bbi + p * 16 + h2), bi1 = *(LAS const f32x4*)(bbi + p * 16 + h2 + 4);
                float v[8];
#pragma unroll
                for (int j = 0; j < 4; ++j) { v[j] = (row < 64) ? (pr * br0[j] - pi * bi0[j]) : (pr * bi0[j] + pi * br0[j]); v[4 + j] = (row < 64) ? (pr * br1[j] - pi * bi1[j]) : (pr * bi1[j] + pi * br1[j]); }
                u32x4 w; w.x = cvt_pk_bf16(v[0], v[1]); w.y = cvt_pk_bf16(v[2], v[3]); w.z = cvt_pk_bf16(v[4], v[5]); w.w = cvt_pk_bf16(v[6], v[7]);
                *(u32x4*)(PMg + (size_t)row * 256 + c8) = w; }
            if (part == 0 && tid < 64) { A16[(g * NST + tid) * 2] = pwr[16 * 64 + tid]; A16[(g * NST + tid) * 2 + 1] = pwi[16 * 64 + tid]; }
        }
        __syncthreads();
    }
    SEAM(0);
#if PROBE == 4
    for (int i = 0; i < 20; ++i) grid.sync();
#endif
    for (int rep1 = 0; rep1 < (PROBE == 5 ? 2 : 1); ++rep1)
    if (IN(1)) {
        pg8::Gemm g{XN, Wgu1, MTOK, 2 * DFF, DM, DM, DM}; pg8::StaticOrder S; S.init(MTOK, 2 * DFF, G, bx);
        pg8::EpiSwiGLU E{ACT, DFF, nullptr};
        pg8::gemm_phase<pg8::EpiSwiGLU, pg8::StaticOrder>(lds, g, S, E);
    }
    SEAM(1);
    if (IN(2)) {
        pg8::Gemm g{ACT, Wd1, MTOK, DM, DFF, DFF, DFF}; pg8::StaticOrder S; S.init(MTOK, DM, G, bx);
        pg8::EpiResid E{x, out, XN, ss1, 0.5f, (LAS float*)(lds + 131072 + 4096)};
        pg8::gemm_phase<pg8::EpiResid, pg8::StaticOrder>(lds, g, S, E);
    }
    SEAM(2);
    for (int rep3 = 0; rep3 < (PROBE == 7 ? 2 : 1); ++rep3)
    if (IN(3)) {
        pg8::Gemm g{XN, Win, MTOK, DIN, DM, DM, DM}; pg8::StaticOrder S; S.init(MTOK, DIN, G, bx);
        pg8::EpiWin E{QKVU, UP, ss1, KN, (LAS float*)(lds + 131072 + 8192)};
        pg8::gemm_phase<pg8::EpiWin, pg8::StaticOrder>(lds, g, S, E);
    }
    SEAM(3);
    if (IN(4)) {
        float lam;
        { const float a = wave_sum(args.in[7][lane] * args.in[8][lane]), c = wave_sum(args.in[9][lane] * args.in[10][lane]); lam = expf(a) - expf(c) + LAMBDA_INIT; }
        for (int cu = vcu; cu < 256; cu += G) {
            const int b = cu >> 6; const unsigned e = att_tab[cu & 63];
            for (int ui = 0; ui < 4; ++ui) {
                const unsigned u8 = (e >> (8 * ui)) & 255u;
                attn_unit(b, (int)(u8 & 7u), (int)(u8 >> 3), QKVU, QKVU, DIN, KN, lds, lam, args.in[11]);
            }
        }
        if (bx < 256) {
            ssm_unit(bx >> 6, bx & 63, UP, TQ, PM, A16, QKVU, lds, true);
#if PROBE == 2
            ssm_unit(bx >> 6, bx & 63, UP, TQ, PM, A16, QKVU, lds, true);
#endif
#if PROBE == 9
            ssm_unit(bx >> 6, bx & 63, UP, TQ, PM, A16, QKVU, lds, false);
#endif
        }
    }
    SEAM(4);
    for (int rep5 = 0; rep5 < (PROBE == 6 ? 2 : 1); ++rep5)
    if (IN(5)) {
        pg8::Gemm g{QKVU + 3072, Wglu, MTOK, 1024, 1024, DIN, 1024}; pg8::StaticOrder S; S.init(MTOK, 1024, G, bx);
        pg8::EpiGlu E{QKVU, args.in[21]};
        pg8::gemm_phase<pg8::EpiGlu, pg8::StaticOrder>(lds, g, S, E);
    }
    SEAM(5);
    if (IN(6)) {
        pg8::Gemm g{QKVU, Wout, MTOK, DM, DM, DIN, DM}; pg8::StaticOrder S; S.init(MTOK, DM, G, bx);
        pg8::EpiResid E{out, out, XN, ss2, 1.0f, (LAS float*)(lds + 131072 + 4096)};
        pg8::gemm_phase<pg8::EpiResid, pg8::StaticOrder>(lds, g, S, E);
    }
    SEAM(6);
    if (IN(7)) {
        pg8::Gemm g{XN, Wgu2, MTOK, 2 * DFF, DM, DM, DM}; pg8::StaticOrder S; S.init(MTOK, 2 * DFF, G, bx);
        pg8::EpiSwiGLU E{ACT, DFF, ss2};
        pg8::gemm_phase<pg8::EpiSwiGLU, pg8::StaticOrder>(lds, g, S, E);
    }
    SEAM(7);
    const bool fused_tail = (G == 256);
    if (IN(8)) {
        pg8::Gemm g{ACT, Wd2, MTOK, DM, DFF, DFF, DFF};
        if (fused_tail) {
            pg8::FusedOrder S{bx};
            pg8::EpiResidNorm E{out, out, ss3, (unsigned*)(ws + WS_PCNT), args.in[27], 0.5f, (LAS float*)(lds + 131072 + 4096)};
            pg8::gemm_phase<pg8::EpiResidNorm, pg8::FusedOrder>(lds, g, S, E);
        } else {
            pg8::StaticOrder S; S.init(MTOK, DM, G, bx);
            pg8::EpiResid E{out, out, nullptr, ss3, 0.5f, (LAS float*)(lds + 131072 + 4096)};
            pg8::gemm_phase<pg8::EpiResid, pg8::StaticOrder>(lds, g, S, E);
        }
    }
    if (!fused_tail) SEAM(8);
    if (IN(9) && !fused_tail) {
        const float* gf = args.in[27];
        const int gw = vcu * 8 + wave, NGW = G * 8;
        f32x4 ggv[8];
#pragma unroll
        for (int j = 0; j < 8; ++j) ggv[j] = *((const f32x4*)gf + lane + 64 * j);
        for (int m = gw; m < MTOK; m += NGW) {
            const float rs = rsqrtf(ss3[m] * (1.0f / DM) + NORM_EPS);
            f32x4* xr = (f32x4*)(out + (size_t)m * DM) + lane;
            f32x4 v[8];
#pragma unroll
            for (int j = 0; j < 8; ++j) v[j] = xr[64 * j];
#pragma unroll
            for (int j = 0; j < 8; ++j) xr[64 * j] = v[j] * rs * ggv[j];
        }
    }
#undef IN
#undef SEAM
}

#ifndef MK_N_LAUNCHES
#define MK_N_LAUNCHES 1
#endif
constexpr int N_PHASES = 10;

extern "C" void kernel_launch(void* const* d_in, const int* in_sizes, int n_in, void* d_out, int out_size, void* d_ws, size_t ws_size, hipStream_t stream) {
    static int grid = 0;
    if (grid == 0) {
        if (n_in != 28 || ws_size < WS_END) { fprintf(stderr, "kernel_launch: unexpected inputs (n_in %d, ws %zu)\n", n_in, ws_size); grid = -1; return; }
        int dev = 0, cus = 0, per_cu = 0;
        (void)hipGetDevice(&dev);
        (void)hipDeviceGetAttribute(&cus, hipDeviceAttributeMultiprocessorCount, dev);
        (void)hipFuncSetAttribute((const void*)mk_fwd, hipFuncAttributeMaxDynamicSharedMemorySize, LDS_BYTES);
        (void)hipOccupancyMaxActiveBlocksPerMultiprocessor(&per_cu, (const void*)mk_fwd, 512, LDS_BYTES);
        if (per_cu < 1) { fprintf(stderr, "kernel_launch: occupancy query reports %d blocks per CU\n", per_cu); per_cu = 1; }
        (void)hipGetLastError();
        grid = cus;
    }
    if (grid < 0) return;
    if (hipMemsetAsync((char*)d_ws + WS_BAR, 0, 16384 + 64 * 256, stream) != hipSuccess) { fprintf(stderr, "kernel_launch: memset of the barrier words failed\n"); return; }
    Args a{};
    for (int i = 0; i < 28; ++i) a.in[i] = (const float*)d_in[i];
    a.out = (float*)d_out; a.ws = (unsigned char*)d_ws;
#if MK_N_LAUNCHES == 1
    a.ph_lo = 0; a.ph_hi = N_PHASES;
    void* kargs[] = {&a};
    hipError_t e = hipLaunchCooperativeKernel((const void*)mk_fwd, dim3(grid), dim3(512), kargs, LDS_BYTES, stream);
    if (e != hipSuccess) fprintf(stderr, "cooperative launch failed: %s (grid %d)\n", hipGetErrorString(e), grid);
#else
    for (int p = 0; p < N_PHASES; ++p) { a.ph_lo = p; a.ph_hi = p + 1; hipLaunchKernelGGL(mk_fwd, dim3(grid), dim3(512), LDS_BYTES, stream, a); }
#endif
}
```

```cpp
#include <hip/hip_runtime.h>
#include <hip/hip_cooperative_groups.h>
#include <cstdio>
#include <cstdint>
#include <cmath>
namespace cg = cooperative_groups;
#ifndef PROBE
#define PROBE 0
#endif

#define LAS __attribute__((address_space(3)))
typedef unsigned short bf16_t;
typedef short bf16x8 __attribute__((ext_vector_type(8)));
typedef short s16x4 __attribute__((ext_vector_type(4)));
typedef float f32x2 __attribute__((ext_vector_type(2)));
typedef float f32x4 __attribute__((ext_vector_type(4)));
typedef float f32x16 __attribute__((ext_vector_type(16)));
typedef unsigned u32x2 __attribute__((ext_vector_type(2)));
typedef unsigned u32x4 __attribute__((ext_vector_type(4)));

constexpr int BATCH = 4, SEQ = 4096, DM = 2048, MTOK = BATCH * SEQ, DFF = 5632, DIN = 4096;
constexpr int NGRP = 64, NST = 64, HGC = 16;
constexpr float NORM_EPS = 1e-6f, SUBLN_EPS = 1e-5f;
constexpr float LOG2E = 1.4426950408889634f;
constexpr float QSCALE = 0.125f * LOG2E;
constexpr float LAMBDA_INIT = 0.2f;

__device__ __forceinline__ unsigned cvt_pk_bf16(float lo, float hi) { unsigned r; asm volatile("v_cvt_pk_bf16_f32 %0, %1, %2" : "=v"(r) : "v"(lo), "v"(hi)); return r; }
typedef __bf16 bf16x2_t __attribute__((ext_vector_type(2)));
__device__ __forceinline__ unsigned cvt_pk_bf16_b(float lo, float hi) { const f32x2 v = {lo, hi}; const bf16x2_t b = __builtin_convertvector(v, bf16x2_t); return __builtin_bit_cast(unsigned, b); }
__device__ __forceinline__ float bf16_to_f32(unsigned short v) { return __uint_as_float(((unsigned)v) << 16); }
__device__ __forceinline__ float wave_sum(float v) {
#pragma unroll
    for (int o = 1; o < 64; o <<= 1) v += __shfl_xor(v, o);
    return v;
}

namespace pg8 {
constexpr int BM = 256, BK = 64, HALF = 128, HTB = HALF * BK * 2, STAGE_BYTES = 8 * HTB, NXCD = 8, WGM = 8;
__host__ __device__ __forceinline__ int lds_byte(int r, int c) { const int st = (r >> 4) * 2 + (c >> 5), rr = r & 15, cc = c & 31, ob = rr * 64 + cc * 2; return st * 1024 + (ob ^ (((ob >> 9) & 1) << 5)); }
__host__ __device__ __forceinline__ void stage_rc(int b, int& R, int& C) { const int st = b / 1024, sb = b % 1024, swz = sb ^ (((sb >> 9) & 1) << 5); R = (st >> 1) * 16 + swz / 64; C = (st & 1) * 32 + (swz % 64) / 2; }
__host__ __device__ __forceinline__ int perm32(int rho) { const int n = rho >> 4, i = rho & 15; return 8 * (i >> 2) + 4 * n + (i & 3); }

struct Unit { int pm, pn; };
struct Gemm { const bf16_t* A; const bf16_t* Bt; int M, N, K, lda, ldb; };

struct StaticOrder {
    int nM, nN, nwg, G, c;
    __host__ __device__ void init(int M, int N, int G_, int c_) { nM = M / BM; nN = N / BM; nwg = nM * nN; G = G_; c = c_; }
    __host__ __device__ bool next(int i, Unit& u) const {
        const long L = (long)i * G + c; if (L >= nwg) return false;
        int wgid = (int)L; { const int q = nwg / NXCD, r = nwg % NXCD, xcd = wgid % NXCD, off = wgid / NXCD; wgid = (xcd < r ? xcd * (q + 1) : r * (q + 1) + (xcd - r) * q) + off; }
        const int nig = WGM * nN, gid = wgid / nig, fm = gid * WGM, gsz = (nM - fm) < WGM ? (nM - fm) : WGM;
        u.pm = fm + ((wgid % nig) % gsz); u.pn = (wgid % nig) / gsz; return true;
    }
};


struct EpiSwiGLU {
    static constexpr bool PERM = true;
    bf16_t* O; int ldc; const float* ss;
    mutable int pmc = -1; mutable float rsc[2][4] = {};
    __device__ __forceinline__ void operator()(const f32x4 (&acc)[2][2][4][2], const Unit& u, int wr, int wc, int fr, int fq) const {
        const int row0 = u.pm * BM + wr * 64 + fr, col0 = u.pn * HALF + wc * 32 + 8 * fq;
        if (ss && u.pm != pmc) {
            float rsv[2][4];
#pragma unroll
            for (int ai = 0; ai < 2; ++ai)
#pragma unroll
                for (int m = 0; m < 4; ++m) rsv[ai][m] = ss[row0 + ai * HALF + m * 16];
#pragma unroll
            for (int ai = 0; ai < 2; ++ai)
#pragma unroll
                for (int m = 0; m < 4; ++m) rsc[ai][m] = rsqrtf(rsv[ai][m] * (1.0f / DM) + NORM_EPS);
            pmc = u.pm;
        }
#pragma unroll
        for (int ai = 0; ai < 2; ++ai)
#pragma unroll
            for (int m = 0; m < 4; ++m) {
                const int row = row0 + ai * HALF + m * 16;
                const float rs = ss ? rsc[ai][m] : 1.0f;
                float o[8];
#pragma unroll
                for (int n = 0; n < 2; ++n)
#pragma unroll
                    for (int j = 0; j < 4; ++j) { const float gt = acc[ai][0][m][n][j] * rs, up = acc[ai][1][m][n][j] * rs;
                        o[n * 4 + j] = gt * __builtin_amdgcn_rcpf(1.0f + __expf(-gt)) * up; }
                u32x4 w; w.x = cvt_pk_bf16(o[0], o[1]); w.y = cvt_pk_bf16(o[2], o[3]); w.z = cvt_pk_bf16(o[4], o[5]); w.w = cvt_pk_bf16(o[6], o[7]);
                *(u32x4*)(O + (size_t)row * ldc + col0) = w;
            }
    }
};
struct EpiResid {
    static constexpr bool PERM = true;
    const float* base; float* out; bf16_t* xb; float* ss; float alpha; LAS float* part;
    __device__ __forceinline__ void operator()(const f32x4 (&acc)[2][2][4][2], const Unit& u, int wr, int wc, int fr, int fq) const {
        const int row0 = u.pm * BM + wr * 64 + fr, col0 = u.pn * BM + wc * 32 + 8 * fq;
#pragma unroll
        for (int ai = 0; ai < 2; ++ai) {
#pragma unroll
          for (int mh = 0; mh < 2; ++mh) {
          f32x4 bb[2][2][2];
#pragma unroll
          for (int m2 = 0; m2 < 2; ++m2)
#pragma unroll
            for (int bj = 0; bj < 2; ++bj) { const size_t off = (size_t)(row0 + ai * HALF + (2 * mh + m2) * 16) * DM + col0 + bj * HALF;
                bb[m2][bj][0] = *(const f32x4*)(base + off); bb[m2][bj][1] = *(const f32x4*)(base + off + 4); }
#pragma unroll
            for (int m2 = 0; m2 < 2; ++m2) { const int m = 2 * mh + m2;
                const int row = row0 + ai * HALF + m * 16; float sq = 0.f;
#pragma unroll
                for (int bj = 0; bj < 2; ++bj) {
                    const size_t off = (size_t)row * DM + col0 + bj * HALF;
                    const f32x4 b0 = bb[m2][bj][0], b1 = bb[m2][bj][1];
                    const f32x4 v0 = b0 + acc[ai][bj][m][0] * alpha, v1 = b1 + acc[ai][bj][m][1] * alpha;
                    *(f32x4*)(out + off) = v0; *(f32x4*)(out + off + 4) = v1;
                    sq += (v0[0] * v0[0] + v0[1] * v0[1]) + (v0[2] * v0[2] + v0[3] * v0[3]) + (v1[0] * v1[0] + v1[1] * v1[1]) + (v1[2] * v1[2] + v1[3] * v1[3]);
                    if (xb) { u32x4 w; w.x = cvt_pk_bf16(v0[0], v0[1]); w.y = cvt_pk_bf16(v0[2], v0[3]); w.z = cvt_pk_bf16(v1[0], v1[1]); w.w = cvt_pk_bf16(v1[2], v1[3]); *(u32x4*)(xb + off) = w; }
                }
                sq += __shfl_xor(sq, 16); sq += __shfl_xor(sq, 32);
                if (fq == 0) part[(row - u.pm * BM) * 4 + wc] = sq;
            }
          }
        }
        asm volatile("s_waitcnt lgkmcnt(0)" ::: "memory"); __builtin_amdgcn_s_barrier();
        { const int t_ = (wr * 4 + wc) * 64 + fq * 16 + fr;
          if (t_ < 256) { const f32x4 p = *(LAS const f32x4*)(part + t_ * 4); atomicAdd(ss + u.pm * BM + t_, (p[0] + p[1]) + (p[2] + p[3])); } }
    }
};
struct EpiWin {
    static constexpr bool PERM = true;
    bf16_t* QKVU; bf16_t* UP; const float* ss; float* knorm2; LAS float* kpart;
    mutable int pmc = -1; mutable float rsc[2][4] = {};
    __device__ __forceinline__ void operator()(const f32x4 (&acc)[2][2][4][2], const Unit& u, int wr, int wc, int fr, int fq) const {
        const int row0 = u.pm * BM + wr * 64 + fr, col0 = u.pn * BM + wc * 32 + 8 * fq;
        const float cs = (u.pn < 4) ? QSCALE : 1.0f;
        if (u.pm != pmc) {
            float rsv[2][4];
#pragma unroll
            for (int ai = 0; ai < 2; ++ai)
#pragma unroll
                for (int m = 0; m < 4; ++m) rsv[ai][m] = ss[row0 + ai * HALF + m * 16];
#pragma unroll
            for (int ai = 0; ai < 2; ++ai)
#pragma unroll
                for (int m = 0; m < 4; ++m) rsc[ai][m] = rsqrtf(rsv[ai][m] * (1.0f / DM) + NORM_EPS);
            pmc = u.pm;
        }
#pragma unroll
        for (int ai = 0; ai < 2; ++ai)
#pragma unroll
            for (int m = 0; m < 4; ++m) {
                const int row = row0 + ai * HALF + m * 16;
                const float rs = rsc[ai][m] * cs;
#pragma unroll
                for (int bj = 0; bj < 2; ++bj) {
                    const f32x4 v0 = acc[ai][bj][m][0] * rs, v1 = acc[ai][bj][m][1] * rs;
                    u32x4 w; w.x = cvt_pk_bf16(v0[0], v0[1]); w.y = cvt_pk_bf16(v0[2], v0[3]); w.z = cvt_pk_bf16(v1[0], v1[1]); w.w = cvt_pk_bf16(v1[2], v1[3]);
                    const int col = col0 + bj * HALF;
                    if (u.pn >= 4 && u.pn < 8) {
                        float sq = (v0[0] * v0[0] + v0[1] * v0[1]) + (v0[2] * v0[2] + v0[3] * v0[3]) + (v1[0] * v1[0] + v1[1] * v1[1]) + (v1[2] * v1[2] + v1[3] * v1[3]);
                        sq += __shfl_xor(sq, 16); sq += __shfl_xor(sq, 32);
                        if (fq == 0) kpart[((row - u.pm * BM) * 4 + 2 * bj + (wc >> 1)) * 2 + (wc & 1)] = sq;
                    }
                    if (u.pn < 12) *(u32x4*)(QKVU + (size_t)row * DIN + col) = w;
                    else { const int cu = col - 3072, g = cu >> 4, ch = cu & 15, b = row >> 12, t = row & 4095;
                           *(u32x4*)(UP + ((size_t)(b * NGRP + g) * SEQ + t) * HGC + ch) = w; }
                }
            }
        if (u.pn >= 4 && u.pn < 8) {
            asm volatile("s_waitcnt lgkmcnt(0)" ::: "memory"); __builtin_amdgcn_s_barrier();
            const int t_ = (wr * 4 + wc) * 64 + fq * 16 + fr, rowb = u.pm * BM;
#pragma unroll
            for (int i = 0; i < 2; ++i) { const int idx = t_ + 512 * i, hcl = idx >> 8, rl = idx & 255;
                const f32x2 p = *(LAS const f32x2*)(kpart + (rl * 4 + hcl) * 2);
                atomicAdd(knorm2 + (size_t)(((rowb + rl) >> 12) * 16 + 4 * (u.pn - 4) + hcl) * SEQ + ((rowb + rl) & 4095), p[0] + p[1]); }
        }
    }
};
struct EpiGlu {
    static constexpr bool PERM = true;
    bf16_t* QKVU; const float* bias;
    __device__ __forceinline__ void operator()(const f32x4 (&acc)[2][2][4][2], const Unit& u, int wr, int wc, int fr, int fq) const {
        const int row0 = u.pm * BM + wr * 64 + fr, col0 = u.pn * BM + wc * 32 + 8 * fq;
        f32x4 bv[2][2];
#pragma unroll
        for (int bj = 0; bj < 2; ++bj) { bv[bj][0] = *(const f32x4*)(bias + col0 + bj * HALF); bv[bj][1] = *(const f32x4*)(bias + col0 + bj * HALF + 4); }
#pragma unroll
        for (int ai = 0; ai < 2; ++ai) {
          u32x4 gwv[4][2];
#pragma unroll
            for (int m = 0; m < 4; ++m)
#pragma unroll
                for (int bj = 0; bj < 2; ++bj) gwv[m][bj] = *(const u32x4*)(QKVU + (size_t)(row0 + ai * HALF + m * 16) * DIN + 3072 + col0 + bj * HALF);
#pragma unroll
            for (int m = 0; m < 4; ++m) {
                const int row = row0 + ai * HALF + m * 16;
#pragma unroll
                for (int bj = 0; bj < 2; ++bj) {
                    const int col = col0 + bj * HALF;
                    const u32x4 gw = gwv[m][bj];
                    const f32x4 b0 = bv[bj][0], b1 = bv[bj][1];
                    float o[8];
#pragma unroll
                    for (int j = 0; j < 4; ++j) {
                        const unsigned gword0 = gw[j >> 1], gword1 = gw[2 + (j >> 1)];
                        const float g0 = (j & 1) ? __uint_as_float(gword0 & 0xffff0000u) : __uint_as_float(gword0 << 16);
                        const float g1 = (j & 1) ? __uint_as_float(gword1 & 0xffff0000u) : __uint_as_float(gword1 << 16);
                        const float z0 = acc[ai][bj][m][0][j] + b0[j], z1 = acc[ai][bj][m][1][j] + b1[j];
                        o[j] = g0 * __builtin_amdgcn_rcpf(1.0f + __expf(-z0)); o[4 + j] = g1 * __builtin_amdgcn_rcpf(1.0f + __expf(-z1));
                    }
                    u32x4 w; w.x = cvt_pk_bf16(o[0], o[1]); w.y = cvt_pk_bf16(o[2], o[3]); w.z = cvt_pk_bf16(o[4], o[5]); w.w = cvt_pk_bf16(o[6], o[7]);
                    *(u32x4*)(QKVU + (size_t)row * DIN + 1024 + col) = w;
                }
            }
        }
    }
};

struct EpiResidNorm {
    static constexpr bool PERM = true;
    const float* base; float* out; float* ss; unsigned* cnt; const float* gain; float alpha; LAS float* part;
    __device__ __forceinline__ void operator()(f32x4 (&acc)[2][2][4][2], const Unit& u, int wr, int wc, int fr, int fq) const {
        const int row0 = u.pm * BM + wr * 64 + fr, col0 = u.pn * BM + wc * 32 + 8 * fq;
#pragma unroll
        for (int ai = 0; ai < 2; ++ai) {
#pragma unroll
          for (int mh = 0; mh < 2; ++mh) {
          f32x4 bb[2][2][2];
#pragma unroll
          for (int m2 = 0; m2 < 2; ++m2)
#pragma unroll
            for (int bj = 0; bj < 2; ++bj) { const size_t off = (size_t)(row0 + ai * HALF + (2 * mh + m2) * 16) * DM + col0 + bj * HALF;
                bb[m2][bj][0] = *(const f32x4*)(base + off); bb[m2][bj][1] = *(const f32x4*)(base + off + 4); }
#pragma unroll
            for (int m2 = 0; m2 < 2; ++m2) { const int m = 2 * mh + m2;
                const int row = row0 + ai * HALF + m * 16; float sq = 0.f;
#pragma unroll
                for (int bj = 0; bj < 2; ++bj) {
                    const f32x4 v0 = bb[m2][bj][0] + acc[ai][bj][m][0] * alpha, v1 = bb[m2][bj][1] + acc[ai][bj][m][1] * alpha;
                    acc[ai][bj][m][0] = v0; acc[ai][bj][m][1] = v1;
                    sq += (v0[0] * v0[0] + v0[1] * v0[1]) + (v0[2] * v0[2] + v0[3] * v0[3]) + (v1[0] * v1[0] + v1[1] * v1[1]) + (v1[2] * v1[2] + v1[3] * v1[3]);
                }
                sq += __shfl_xor(sq, 16); sq += __shfl_xor(sq, 32);
                if (fq == 0) part[(row - u.pm * BM) * 4 + wc] = sq;
            }
          }
        }
        f32x4 gv[2][2];
#pragma unroll
        for (int bj = 0; bj < 2; ++bj) { gv[bj][0] = *(const f32x4*)(gain + col0 + bj * HALF); gv[bj][1] = *(const f32x4*)(gain + col0 + bj * HALF + 4); }
        asm volatile("s_waitcnt lgkmcnt(0)" ::: "memory"); __builtin_amdgcn_s_barrier();
        { const int t_ = (wr * 4 + wc) * 64 + fq * 16 + fr;
          if (t_ < 256) { const f32x4 p = *(LAS const f32x4*)(part + t_ * 4); atomicAdd(ss + u.pm * BM + t_, (p[0] + p[1]) + (p[2] + p[3])); } }
        asm volatile("s_waitcnt vmcnt(0)" ::: "memory");
        __builtin_amdgcn_s_barrier();
        if (wr == 0 && wc == 0) {
            unsigned* c = cnt + 64 * u.pm;
            __builtin_amdgcn_fence(__ATOMIC_RELEASE, "agent");
            asm volatile("s_waitcnt vmcnt(0)" ::: "memory");
            if (fr == 0 && fq == 0) (void)__hip_atomic_fetch_add(c, 1u, __ATOMIC_RELAXED, __HIP_MEMORY_SCOPE_AGENT);
            unsigned sp = 0;
            while (__hip_atomic_load(c, __ATOMIC_RELAXED, __HIP_MEMORY_SCOPE_AGENT) < 8u) { __builtin_amdgcn_s_sleep(8); if (++sp > (1u << 21)) break; }
            __builtin_amdgcn_fence(__ATOMIC_ACQUIRE, "agent");
            asm volatile("s_waitcnt vmcnt(0)" ::: "memory");
        }
        __builtin_amdgcn_s_barrier();
        float rsv[2][4];
#pragma unroll
        for (int ai = 0; ai < 2; ++ai)
#pragma unroll
            for (int m = 0; m < 4; ++m) rsv[ai][m] = __hip_atomic_load(ss + row0 + ai * HALF + m * 16, __ATOMIC_RELAXED, __HIP_MEMORY_SCOPE_AGENT);
#pragma unroll
        for (int ai = 0; ai < 2; ++ai)
#pragma unroll
            for (int m = 0; m < 4; ++m) { const float rs = rsqrtf(rsv[ai][m] * (1.0f / DM) + NORM_EPS);
#pragma unroll
                for (int bj = 0; bj < 2; ++bj) { const size_t off = (size_t)(row0 + ai * HALF + m * 16) * DM + col0 + bj * HALF;
                    *(f32x4*)(out + off) = acc[ai][bj][m][0] * rs * gv[bj][0]; *(f32x4*)(out + off + 4) = acc[ai][bj][m][1] * rs * gv[bj][1]; } }
    }
};
struct FusedOrder {
    int c;
    __host__ __device__ bool next(int i, Unit& u) const { if (i >= 2) return false; u.pm = 32 * i + 4 * (c & 7) + (c >> 6); u.pn = (c >> 3) & 7; return true; }
};

template <class Epi, class Sched, bool ALIGN_EPI = true, bool SP2 = true>
__device__ __forceinline__ void gemm_phase(LAS unsigned char* lds, const Gemm g, const Sched& S, const Epi& E) {
    int tid = threadIdx.x; asm volatile("" : "+v"(tid));
    const int wid = __builtin_amdgcn_readfirstlane(tid >> 6), lane = tid & 63, wr = wid >> 2, wc = wid & 3, fr = lane & 15, fq = lane >> 4;
    const int K = g.K, nt = K / BK;
    unsigned voffA[2], voffB[2];
#pragma unroll
    for (int i = 0; i < 2; ++i) { int R, C; stage_rc(tid * 16 + i * 8192, R, C); const int Rb = Epi::PERM ? ((R & ~31) + perm32(R & 31)) : R;
        voffA[i] = (unsigned)(R * g.lda + C) * 2u; voffB[i] = (unsigned)(Rb * g.ldb + C) * 2u; }
    const size_t kstep = (size_t)(BK * 2);
    const size_t hA = (size_t)HALF * g.lda * 2, hB = (size_t)HALF * g.ldb * 2;
    const size_t tA = 2 * hA, tB = 2 * hB;
    const unsigned ldsw = (unsigned)wid * 1024u;
    const int aoff = lds_byte(wr * 64 + fr, fq * 8), boff = lds_byte(wc * 32 + fr, fq * 8);
#define PG8_SA(b, h) (((b) * 2 + (h)) * HTB)
#define PG8_SB(b, h) ((4 + (b) * 2 + (h)) * HTB)
#define PG8_STAGE(bufoff, gbase, voff) do { _Pragma("unroll") for (int _i = 0; _i < 2; ++_i) \
        __builtin_amdgcn_global_load_lds((const unsigned*)((const char*)(gbase) + (voff)[_i]), (LAS unsigned*)(lds + (bufoff) + ldsw + _i * 8192), 16, 0, 0); } while (0)
#define PG8_LDA(dst, b, h) do { _Pragma("unroll") for (int m = 0; m < 4; ++m) _Pragma("unroll") for (int k = 0; k < 2; ++k) dst[m][k] = *(const LAS bf16x8*)(lds + PG8_SA(b, h) + aoff + m * 2048 + k * 1024); } while (0)
#define PG8_LDB(dst, b, h) do { _Pragma("unroll") for (int n = 0; n < 2; ++n) _Pragma("unroll") for (int k = 0; k < 2; ++k) dst[n][k] = *(const LAS bf16x8*)(lds + PG8_SB(b, h) + boff + n * 2048 + k * 1024); } while (0)
#define PG8_MMA(ai, bj, At, Bt) do { __builtin_amdgcn_s_setprio(1); _Pragma("unroll") for (int m = 0; m < 4; ++m) _Pragma("unroll") for (int n = 0; n < 2; ++n) _Pragma("unroll") for (int k = 0; k < 2; ++k) \
        acc[ai][bj][m][n] = __builtin_amdgcn_mfma_f32_16x16x32_bf16(Bt[n][k], At[m][k], acc[ai][bj][m][n], 0, 0, 0); __builtin_amdgcn_s_setprio(0); } while (0)
#define PG8_WAIT_V(n) asm volatile("s_waitcnt vmcnt(" #n ")" ::: "memory")
#define PG8_WAIT_L(n) asm volatile("s_waitcnt lgkmcnt(" #n ")" ::: "memory")
#define PG8_BAR __builtin_amdgcn_s_barrier()
#define PG8_SCHED __builtin_amdgcn_sched_barrier(0)
    Unit cur, nxt; int ui = 0;
    if (!S.next(0, cur)) return;
    f32x4 acc[2][2][4][2];
#pragma unroll
    for (int a = 0; a < 2; ++a)
#pragma unroll
        for (int b = 0; b < 2; ++b)
#pragma unroll
            for (int m = 0; m < 4; ++m)
#pragma unroll
                for (int n = 0; n < 2; ++n) acc[a][b][m][n] = (f32x4){0.f, 0.f, 0.f, 0.f};
    bf16x8 At[4][2], B0[2][2], B1[2][2];
    const char* cA = (const char*)g.A + (size_t)cur.pm * tA; const char* cB = (const char*)g.Bt + (size_t)cur.pn * tB;
    if constexpr (SP2) {
        PG8_STAGE(PG8_SB(0, 0), cB, voffB); PG8_STAGE(PG8_SB(0, 1), cB + hB, voffB); PG8_STAGE(PG8_SA(0, 0), cA, voffA); PG8_STAGE(PG8_SA(0, 1), cA + hA, voffA);
        if (wr == 1) PG8_BAR;
        PG8_WAIT_V(2); PG8_BAR;
        PG8_STAGE(PG8_SB(1, 0), cB + kstep, voffB); PG8_STAGE(PG8_SA(1, 0), cA + kstep, voffA); PG8_STAGE(PG8_SB(1, 1), cB + hB + kstep, voffB);
        PG8_WAIT_V(6); PG8_BAR;
    } else {
        PG8_STAGE(PG8_SB(0, 0), cB, voffB); PG8_STAGE(PG8_SA(0, 0), cA, voffA); PG8_STAGE(PG8_SB(0, 1), cB + hB, voffB); PG8_STAGE(PG8_SA(0, 1), cA + hA, voffA);
        if (wr == 1) PG8_BAR;
        PG8_WAIT_V(4); PG8_BAR;
        PG8_STAGE(PG8_SB(1, 0), cB + kstep, voffB); PG8_STAGE(PG8_SA(1, 0), cA + kstep, voffA); PG8_STAGE(PG8_SB(1, 1), cB + hB + kstep, voffB);
        PG8_WAIT_V(6); PG8_BAR;
    }
    for (;;) {
        const bool has_next = S.next(ui + 1, nxt);
        const char* nA = has_next ? (const char*)g.A + (size_t)nxt.pm * tA : cA; const char* nB = has_next ? (const char*)g.Bt + (size_t)nxt.pn * tB : cB;
        for (int t = 0; t < nt; t += 2) {
            const bool last = (t == nt - 2);
            const char* a1 = cA + (size_t)(t + 1) * kstep;
            const char* a2 = last ? nA : cA + (size_t)(t + 2) * kstep; const char* b2 = last ? nB : cB + (size_t)(t + 2) * kstep;
            const char* a3 = a2 + kstep; const char* b3 = b2 + kstep;
            if constexpr (SP2) {
            PG8_LDB(B0, 0, 0); PG8_LDB(B1, 0, 1); PG8_SCHED; PG8_LDA(At, 0, 0); PG8_STAGE(PG8_SA(1, 1), a1 + hA, voffA);
            PG8_WAIT_V(8); PG8_WAIT_L(0); PG8_BAR; PG8_MMA(0, 0, At, B0); PG8_MMA(0, 1, At, B1); PG8_BAR; PG8_SCHED;
            PG8_LDA(At, 0, 1); PG8_STAGE(PG8_SB(0, 0), b2, voffB); PG8_STAGE(PG8_SB(0, 1), b2 + hB, voffB); PG8_STAGE(PG8_SA(0, 0), a2, voffA);
            PG8_WAIT_V(8); PG8_WAIT_L(0); PG8_BAR; PG8_MMA(1, 0, At, B0); PG8_MMA(1, 1, At, B1); PG8_BAR; PG8_SCHED;
            PG8_LDB(B0, 1, 0); PG8_LDB(B1, 1, 1); PG8_SCHED; PG8_LDA(At, 1, 0); PG8_STAGE(PG8_SA(0, 1), a2 + hA, voffA);
            PG8_WAIT_V(8); PG8_WAIT_L(0); PG8_BAR; PG8_MMA(0, 0, At, B0); PG8_MMA(0, 1, At, B1); PG8_BAR; PG8_SCHED;
            PG8_LDA(At, 1, 1); PG8_STAGE(PG8_SB(1, 0), b3, voffB); PG8_STAGE(PG8_SB(1, 1), b3 + hB, voffB); PG8_STAGE(PG8_SA(1, 0), a3, voffA);
            PG8_WAIT_V(8); PG8_WAIT_L(0); PG8_BAR; PG8_MMA(1, 0, At, B0); PG8_MMA(1, 1, At, B1); PG8_BAR; PG8_SCHED;
            } else {
            PG8_LDB(B0, 0, 0); PG8_SCHED; PG8_LDA(At, 0, 0); PG8_STAGE(PG8_SA(1, 1), a1 + hA, voffA);
            PG8_WAIT_L(8); PG8_BAR; PG8_WAIT_L(0); PG8_MMA(0, 0, At, B0); PG8_BAR; PG8_SCHED;
            PG8_LDB(B1, 0, 1); PG8_STAGE(PG8_SB(0, 0), b2, voffB);
            PG8_BAR; PG8_WAIT_L(0); PG8_MMA(0, 1, At, B1); PG8_BAR;
            PG8_LDA(At, 0, 1); PG8_STAGE(PG8_SA(0, 0), a2, voffA);
            PG8_BAR; PG8_WAIT_L(0); PG8_MMA(1, 0, At, B0); PG8_BAR; PG8_SCHED;
            PG8_STAGE(PG8_SB(0, 1), b2 + hB, voffB);
            PG8_WAIT_V(6); PG8_BAR; PG8_MMA(1, 1, At, B1); PG8_BAR;
            PG8_LDB(B0, 1, 0); PG8_SCHED; PG8_LDA(At, 1, 0); PG8_STAGE(PG8_SA(0, 1), a2 + hA, voffA);
            PG8_WAIT_L(8); PG8_BAR; PG8_WAIT_L(0); PG8_MMA(0, 0, At, B0); PG8_BAR; PG8_SCHED;
            PG8_LDB(B1, 1, 1); PG8_STAGE(PG8_SB(1, 0), b3, voffB);
            PG8_BAR; PG8_WAIT_L(0); PG8_MMA(0, 1, At, B1); PG8_BAR;
            PG8_LDA(At, 1, 1); PG8_STAGE(PG8_SA(1, 0), a3, voffA);
            PG8_BAR; PG8_WAIT_L(0); PG8_MMA(1, 0, At, B0); PG8_BAR; PG8_SCHED;
            PG8_STAGE(PG8_SB(1, 1), b3 + hB, voffB);
            PG8_WAIT_V(6); PG8_BAR; PG8_MMA(1, 1, At, B1); PG8_BAR;
            }
        }
        if constexpr (ALIGN_EPI) { if (wr == 0) PG8_BAR; }
        E(acc, cur, wr, wc, fr, fq);
        if (!has_next) break;
#pragma unroll
        for (int a = 0; a < 2; ++a)
#pragma unroll
            for (int b = 0; b < 2; ++b)
#pragma unroll
                for (int m = 0; m < 4; ++m)
#pragma unroll
                    for (int n = 0; n < 2; ++n) acc[a][b][m][n] = (f32x4){0.f, 0.f, 0.f, 0.f};
        cur = nxt; cA = nA; cB = nB; ++ui;
        if constexpr (ALIGN_EPI) { if (wr == 1) PG8_BAR; }
    }
    PG8_WAIT_V(0);
    if constexpr (!ALIGN_EPI) { if (wr == 0) PG8_BAR; }
    PG8_BAR;
#undef PG8_SA
#undef PG8_SB
#undef PG8_STAGE
#undef PG8_LDA
#undef PG8_LDB
#undef PG8_MMA
#undef PG8_WAIT_V
#undef PG8_WAIT_L
#undef PG8_BAR
#undef PG8_SCHED
}
}

constexpr size_t MiB = 1u << 20;
constexpr size_t WS_SS1 = 0, WS_SS2 = 65536, WS_SS3 = 131072, WS_A16 = 262144, WS_BAR = 524288, WS_PCNT = 524288 + 16384;
constexpr size_t WS_WGU1 = 1 * MiB, WS_WD1 = 45 * MiB, WS_WIN = 67 * MiB, WS_WGLU = 83 * MiB, WS_WOUT = 85 * MiB, WS_WGU2 = 93 * MiB, WS_WD2 = 137 * MiB;
constexpr size_t WS_TQ = 159 * MiB, WS_PM = 171 * MiB, WS_XN = 175 * MiB, WS_ACT = 239 * MiB, WS_KN = 415 * MiB, WS_END = 416 * MiB;
constexpr size_t WS_QKVU = WS_ACT, WS_UP = WS_ACT + 128 * MiB;
constexpr int LDS_BYTES = 131072 + 16384;

struct Args { const float* in[28]; float* out; unsigned char* ws; int ph_lo, ph_hi; };

__device__ __forceinline__ int drow_map(int n, int mode) { return mode == 0 ? n : ((n >> 7) * 256 + (n & 127) + (mode == 2 ? 128 : 0)); }
__device__ __forceinline__ void tr_item(const float* __restrict__ W, int K, int N, bf16_t* WT, const float* __restrict__ ksc, int mode, LAS float* scr, int item, int lane) {
    const int nblk = N / 32, kb = item / nblk, nb = item % nblk, k0 = 64 * kb, n0 = 32 * nb;
    const int r8 = lane >> 3, c4 = lane & 7;
    f32x4 v[8];
#pragma unroll
    for (int i = 0; i < 8; ++i) v[i] = *(const f32x4*)(W + (size_t)(k0 + 8 * i + r8) * N + n0 + 4 * c4);
    if (ksc) {
#pragma unroll
        for (int i = 0; i < 8; ++i) v[i] = v[i] * ksc[k0 + 8 * i + r8];
    }
#pragma unroll
    for (int i = 0; i < 8; ++i) { LAS float* d = scr + (8 * i + r8) * 33 + 4 * c4; d[0] = v[i][0]; d[1] = v[i][1]; d[2] = v[i][2]; d[3] = v[i][3]; }
    asm volatile("s_waitcnt lgkmcnt(0)" ::: "memory");
    const int c = lane & 7;
#pragma unroll
    for (int j = 0; j < 4; ++j) { const int n = (lane >> 3) + 8 * j; const LAS float* s = scr + (8 * c) * 33 + n;
        u32x4 o; o.x = cvt_pk_bf16(s[0 * 33], s[1 * 33]); o.y = cvt_pk_bf16(s[2 * 33], s[3 * 33]); o.z = cvt_pk_bf16(s[4 * 33], s[5 * 33]); o.w = cvt_pk_bf16(s[6 * 33], s[7 * 33]);
        *(u32x4*)(WT + (size_t)drow_map(n0 + n, mode) * K + k0 + 8 * c) = o; }
    asm volatile("s_waitcnt lgkmcnt(0)" ::: "memory");
}

__device__ __forceinline__ int crow(int r, int hi) { return (r & 3) + 8 * (r >> 2) + 4 * hi; }
__device__ __forceinline__ s16x4 tr_read(LAS const char* p) {
    typedef short v4i16_t __attribute__((ext_vector_type(4)));
    return __builtin_bit_cast(s16x4, __builtin_amdgcn_ds_read_tr16_b64_v4i16((LAS v4i16_t*)p));
}
__device__ __forceinline__ void attn_unit(int b, int h, int qb, const bf16_t* QKVU, bf16_t* Obuf, int ldo, const float* __restrict__ knorm2, LAS unsigned char* lds, float lam, const float* __restrict__ subln_g) {
    const int tid = threadIdx.x, lane = tid & 63, wid = __builtin_amdgcn_readfirstlane(tid >> 6), comp = wid >> 2, qw = wid & 3, r32 = lane & 31, hi = lane >> 5;
    const size_t rowbase = (size_t)b * SEQ;
    const int q0 = qb * 128, qpos = q0 + 32 * qw + r32, qmin = q0 + 32 * qw;
    const bf16_t* Qp = QKVU + (rowbase + qpos) * DIN + h * 128 + comp * 64;
    bf16x8 qr[4];
#pragma unroll
    for (int d0 = 0; d0 < 4; ++d0) qr[d0] = *(const bf16x8*)(Qp + d0 * 16 + hi * 8);
    const float slope2 = exp2f(-(float)(h + 1)) * LOG2E;
    const int NT = 2 * qb + 2;
    const bf16_t* Kg = QKVU + rowbase * DIN + 1024 + h * 128;
    const bf16_t* Vg = QKVU + rowbase * DIN + 2048 + h * 128;
    const int krow = 8 * wid + (lane >> 3), kpc = lane & 7, kchk = kpc ^ ((krow >> 1) & 7);
    const int vrw0 = 4 * wid + (lane >> 4), vrw1 = vrw0 + 32, vpc = lane & 15;
    const int vchk0 = vpc ^ (((vrw0 & 3) << 2) | ((vrw0 >> 2) & 3)), vchk1 = vpc ^ (((vrw1 & 3) << 2) | ((vrw1 >> 2) & 3));
    const bf16_t* ksrc = Kg + (size_t)krow * DIN + kchk * 8;
    const bf16_t* vsrc0 = Vg + (size_t)vrw0 * DIN + vchk0 * 8;
    const bf16_t* vsrc1 = Vg + (size_t)vrw1 * DIN + vchk1 * 8;
#define ATT_DMA(t, buf) do { const size_t go_ = (size_t)(t) * 64 * DIN; LAS unsigned char* sb_ = lds + ((buf) & 3) * 32768 + wid * 1024; \
        __builtin_amdgcn_global_load_lds((const unsigned*)(ksrc + go_), (LAS unsigned*)(sb_), 16, 0, 0); \
        __builtin_amdgcn_global_load_lds((const unsigned*)(ksrc + go_ + 64), (LAS unsigned*)(sb_ + 8192), 16, 0, 0); \
        __builtin_amdgcn_global_load_lds((const unsigned*)(vsrc0 + go_), (LAS unsigned*)(sb_ + 16384), 16, 0, 0); \
        __builtin_amdgcn_global_load_lds((const unsigned*)(vsrc1 + go_), (LAS unsigned*)(sb_ + 24576), 16, 0, 0); } while (0)
    LAS float* red = (LAS float*)(lds + 131072 + 128);
    LAS const float* subg = (LAS const float*)(lds + 131072 + 512);
    LAS unsigned* actf = (LAS unsigned*)(lds + 131072 + 256);
    { const float* kn = knorm2 + (size_t)(b * 16 + 2 * h + comp) * SEQ; const int tq = tid & 255; float mx = 0.f;
      f32x4 knv[4];
#pragma unroll
      for (int j = 0; j < 4; ++j) knv[j] = *(const f32x4*)(kn + (j * 256 + tq) * 4);
      ATT_DMA(NT - 1, (NT - 1) & 3); ATT_DMA(NT >= 2 ? NT - 2 : 0, (NT - 2) & 3); ATT_DMA(NT >= 3 ? NT - 3 : 0, (NT - 3) & 3);
#pragma unroll
      for (int j = 0; j < 4; ++j) { const f32x4 v = knv[j]; mx = fmaxf(fmaxf(mx, fmaxf(v[0], v[1])), fmaxf(v[2], v[3])); }
#pragma unroll
      for (int o = 1; o < 64; o <<= 1) mx = fmaxf(mx, __shfl_xor(mx, o));
      if (lane == 0) red[wid] = mx;
      if (tid < 64) actf[tid] = 0u; }
    int vaddr[4][2];
    { const int i16 = lane & 15, q4 = i16 >> 2, p4 = i16 & 3, blk = (lane >> 4) & 1;
#pragma unroll
      for (int dblk = 0; dblk < 4; ++dblk)
#pragma unroll
        for (int ih = 0; ih < 2; ++ih) { const int row = 4 * hi + q4 + 8 * ih, ch = 4 * dblk + 2 * blk + (p4 >> 1), sw = ((row & 3) << 2) | ((row >> 2) & 3);
            vaddr[dblk][ih] = 16384 + row * 256 + ((ch ^ sw) << 4) + 8 * (p4 & 1); } }
    const int kaoff = r32 * 128, ksw = (r32 >> 1) & 7;
    f32x16 o[4];
#pragma unroll
    for (int d = 0; d < 4; ++d)
#pragma unroll
        for (int r = 0; r < 16; ++r) o[d][r] = 0.f;
    float qn = 0.f;
#pragma unroll
    for (int d0 = 0; d0 < 4; ++d0)
#pragma unroll
        for (int j = 0; j < 8; ++j) { const float v = __uint_as_float(((unsigned)(unsigned short)qr[d0][j]) << 16); qn += v * v; }
    qn += __shfl_xor(qn, 32);
    asm volatile("s_waitcnt vmcnt(8) lgkmcnt(0)" ::: "memory");
    __builtin_amdgcn_s_barrier();
    const float kmax = sqrtf(fmaxf(fmaxf(red[4 * comp], red[4 * comp + 1]), fmaxf(red[4 * comp + 2], red[4 * comp + 3])));
    const float bq = sqrtf(qn) * kmax * 1.02f + 1.0f;
    float mrun = 0.f, lrun = 0.f, dq = slope2 * (float)(4 * hi - qpos);
    bool first = true, active = true;
    for (int t = NT - 1; t >= 0; --t) {
        const int buf = t & 3;
        ATT_DMA(t >= 3 ? t - 3 : 0, (t - 3) & 3);
        const int kv0 = t * 64;
        if (active && kv0 <= qmin + 31) {
            const int dmin = qmin - (kv0 + 63);
            if (!first && dmin > 0 && __all((bq - mrun) < slope2 * (float)dmin - 150.0f)) {
                active = false;
            } else {
            LAS const unsigned char* Kb = lds + buf * 32768 + comp * 8192;
            LAS const unsigned char* Sb = lds + buf * 32768;
            f32x16 p0, p1;
            const float dqt = dq + slope2 * (float)kv0;
#pragma unroll
            for (int r = 0; r < 16; ++r) { p0[r] = fmaf(slope2, (float)((r & 3) + 8 * (r >> 2)), dqt); p1[r] = fmaf(slope2, (float)(32 + (r & 3) + 8 * (r >> 2)), dqt); }
            bf16x8 k0f[4], k1f[4];
#pragma unroll
            for (int d0 = 0; d0 < 4; ++d0) {
                const int csw = ((2 * d0 + hi) ^ ksw) << 4;
                k0f[d0] = *(LAS const bf16x8*)(Kb + kaoff + csw);
                k1f[d0] = *(LAS const bf16x8*)(Kb + 4096 + kaoff + csw);
            }
            __builtin_amdgcn_sched_barrier(0);
#pragma unroll
            for (int d0 = 0; d0 < 4; ++d0) {
                p0 = __builtin_amdgcn_mfma_f32_32x32x16_bf16(k0f[d0], qr[d0], p0, 0, 0, 0);
                p1 = __builtin_amdgcn_mfma_f32_32x32x16_bf16(k1f[d0], qr[d0], p1, 0, 0, 0);
            }
            bf16x8 va[4], vb[4];
#define ATT_VREAD(dst, s_) do { _Pragma("unroll") for (int dblk = 0; dblk < 4; ++dblk) { \
                const s16x4 lo_ = tr_read((LAS const char*)(Sb + vaddr[dblk][0] + (s_) * 4096)); const s16x4 hv_ = tr_read((LAS const char*)(Sb + vaddr[dblk][1] + (s_) * 4096)); \
                dst[dblk] = (bf16x8){lo_[0], lo_[1], lo_[2], lo_[3], hv_[0], hv_[1], hv_[2], hv_[3]}; } } while (0)
#define ATT_PV(src, s_) do { _Pragma("unroll") for (int dblk = 0; dblk < 4; ++dblk) o[dblk] = __builtin_amdgcn_mfma_f32_32x32x16_bf16(src[dblk], pf[s_], o[dblk], 0, 0, 0); } while (0)
            ATT_VREAD(va, 0); ATT_VREAD(vb, 1);
            __builtin_amdgcn_sched_barrier(0);
            if (kv0 + 63 > qmin) {
#pragma unroll
                for (int r = 0; r < 16; ++r) { const int kv = kv0 + crow(r, hi); if (kv > qpos) p0[r] = -INFINITY; if (kv + 32 > qpos) p1[r] = -INFINITY; }
            }
            float x = fmaxf(p0[0], p1[0]);
#pragma unroll
            for (int r = 1; r < 16; ++r) x = fmaxf(fmaxf(x, p0[r]), p1[r]);
            x = fmaxf(x, __shfl_xor(x, 32));
            if (first || __any(x > 0.f)) {
                const float xp = first ? x : fmaxf(x, 0.f);
                mrun += xp; dq -= xp;
                const float alpha = __builtin_amdgcn_exp2f(-xp);
                lrun *= alpha;
#pragma unroll
                for (int r = 0; r < 16; ++r) { p0[r] -= xp; p1[r] -= xp; }
                if (!first) {
#pragma unroll
                    for (int d = 0; d < 4; ++d)
#pragma unroll
                        for (int r = 0; r < 16; ++r) o[d][r] *= alpha;
                }
                first = false;
            }
            float sum = 0.f;
#pragma unroll
            for (int r = 0; r < 16; ++r) { p0[r] = __builtin_amdgcn_exp2f(p0[r]); p1[r] = __builtin_amdgcn_exp2f(p1[r]); sum += p0[r] + p1[r]; }
            lrun += sum;
            bf16x8 pf[4];
#pragma unroll
            for (int s = 0; s < 4; ++s) {
                u32x4 w;
                if (s < 2) { w.x = cvt_pk_bf16_b(p0[8 * s + 0], p0[8 * s + 1]); w.y = cvt_pk_bf16_b(p0[8 * s + 2], p0[8 * s + 3]); w.z = cvt_pk_bf16_b(p0[8 * s + 4], p0[8 * s + 5]); w.w = cvt_pk_bf16_b(p0[8 * s + 6], p0[8 * s + 7]); }
                else { const int s2 = s - 2; w.x = cvt_pk_bf16_b(p1[8 * s2 + 0], p1[8 * s2 + 1]); w.y = cvt_pk_bf16_b(p1[8 * s2 + 2], p1[8 * s2 + 3]); w.z = cvt_pk_bf16_b(p1[8 * s2 + 4], p1[8 * s2 + 5]); w.w = cvt_pk_bf16_b(p1[8 * s2 + 6], p1[8 * s2 + 7]); }
                pf[s] = __builtin_bit_cast(bf16x8, w);
            }
            __builtin_amdgcn_sched_barrier(0);
            ATT_PV(va, 0); __builtin_amdgcn_sched_barrier(0);
            ATT_VREAD(va, 2); __builtin_amdgcn_sched_barrier(0);
            ATT_PV(vb, 1); __builtin_amdgcn_sched_barrier(0);
            ATT_VREAD(vb, 3); __builtin_amdgcn_sched_barrier(0);
            ATT_PV(va, 2); __builtin_amdgcn_sched_barrier(0);
            ATT_PV(vb, 3);
#undef ATT_VREAD
#undef ATT_PV
            }
        }
        if (active && lane == 0) actf[t] = 1u;
        asm volatile("s_waitcnt vmcnt(8) lgkmcnt(0)" ::: "memory");
        __builtin_amdgcn_s_barrier();
        if (*(volatile LAS unsigned*)(actf + t) == 0u) break;
    }
#undef ATT_DMA
    lrun += __shfl_xor(lrun, 32);
    const float inv = 1.0f / lrun;
    LAS float* X = (LAS float*)lds;
    asm volatile("s_waitcnt vmcnt(0)" ::: "memory");
    __syncthreads();
    if (comp == 1) {
#pragma unroll
        for (int d = 0; d < 4; ++d)
#pragma unroll
            for (int r = 0; r < 16; ++r) X[(32 * d + crow(r, hi)) * 128 + 32 * qw + r32] = o[d][r] * inv;
    }
    __syncthreads();
    if (comp == 0) {
        float ssq = 0.f;
        f32x16 xv[4];
#pragma unroll
        for (int d = 0; d < 4; ++d)
#pragma unroll
            for (int r = 0; r < 16; ++r) xv[d][r] = X[(32 * d + crow(r, hi)) * 128 + 32 * qw + r32];
        __builtin_amdgcn_sched_barrier(0);
#pragma unroll
        for (int d = 0; d < 4; ++d)
#pragma unroll
            for (int r = 0; r < 16; ++r) { const float v = o[d][r] * inv - lam * xv[d][r]; o[d][r] = v; ssq += v * v; }
        ssq += __shfl_xor(ssq, 32);
        const float sc = rsqrtf(ssq * (1.0f / 128.0f) + SUBLN_EPS) * (1.0f - LAMBDA_INIT);
        bf16_t* Op = Obuf + (rowbase + qpos) * (size_t)ldo + h * 128;
        f32x4 g4v[4][4];
#pragma unroll
        for (int d = 0; d < 4; ++d)
#pragma unroll
            for (int rg = 0; rg < 4; ++rg) g4v[d][rg] = *(LAS const f32x4*)(subg + 32 * d + 8 * rg + 4 * hi);
#pragma unroll
        for (int d = 0; d < 4; ++d)
#pragma unroll
            for (int rg = 0; rg < 4; ++rg) { const int dd = 32 * d + 8 * rg + 4 * hi; const f32x4 g4 = g4v[d][rg];
                u32x2 w; w.x = cvt_pk_bf16(o[d][4 * rg + 0] * sc * g4[0], o[d][4 * rg + 1] * sc * g4[1]); w.y = cvt_pk_bf16(o[d][4 * rg + 2] * sc * g4[2], o[d][4 * rg + 3] * sc * g4[3]);
                *(u32x2*)(Op + dd) = w; }
    }
    __syncthreads();
}

__device__ __forceinline__ float gelu_tanh(float x) {
    const float z = 0.7978845608028654f * (x + 0.044715f * x * x * x);
    return x * __builtin_amdgcn_rcpf(1.0f + __expf(-2.0f * z));
}
__device__ __forceinline__ void ssm_unit(int b, int g, const bf16_t* __restrict__ UP, const bf16_t* __restrict__ TQ, const bf16_t* __restrict__ PM, const float* __restrict__ A16, bf16_t* QKVU, LAS unsigned char* lds, bool do_store = true) {
    const int tid = threadIdx.x, lane = tid & 63, wid = __builtin_amdgcn_readfirstlane(tid >> 6), r32 = lane & 31, hi = lane >> 5;
    LAS unsigned char* UQ = lds;
    LAS float* XL = (LAS float*)(lds + 33792);
    LAS unsigned char* XI = lds + 66560;
    const bf16_t* Ub = UP + (size_t)(b * NGRP + g) * (SEQ * HGC);
    const bf16_t* TQg = TQ + (size_t)g * 256 * 384;
    const bf16_t* PMg = PM + (size_t)g * 128 * 256;
    const float a16r = A16[(g * NST + lane) * 2], a16i = A16[(g * NST + lane) * 2 + 1];
    const int rb1 = wid >> 2, cb1 = wid & 3;
    bf16x8 tq[16];
    const bf16_t* Tp = TQg + (size_t)(32 * wid + r32) * 384 + 8 * hi;
#pragma unroll
    for (int ks = 0; ks < 16; ++ks) tq[ks] = *(const bf16x8*)(Tp + 16 * ks);
    const bf16_t* Pp = PMg + (size_t)(32 * cb1 + r32) * 256 + 8 * hi;
    float sr = 0.f, si = 0.f;
    for (int qi = 0; qi < 4; ++qi) {
        { u32x4 un[4];
#pragma unroll
          for (int j = 0; j < 4; ++j) un[j] = *(const u32x4*)(Ub + (size_t)qi * 16384 + (size_t)(j * 512 + tid) * 8);
#pragma unroll
          for (int j = 0; j < 4; ++j) { const int idx = j * 512 + tid, row = idx >> 5, cc = idx & 31; *(LAS u32x4*)(UQ + row * 528 + cc * 16) = un[j]; } }
        bf16x8 pm[16];
#pragma unroll
        for (int ks = 0; ks < 16; ++ks) pm[ks] = *(const bf16x8*)(Pp + 16 * ks);
        __syncthreads();
        { f32x16 acc;
#pragma unroll
          for (int r = 0; r < 16; ++r) acc[r] = 0.f;
          LAS const unsigned char* ua = UQ + (32 * rb1 + r32) * 528 + 16 * hi;
          bf16x8 fa[4];
#define SSM_XLD(dst, g_) do { _Pragma("unroll") for (int i_ = 0; i_ < 4; ++i_) dst[i_] = *(LAS const bf16x8*)(ua + 32 * (4 * (g_) + i_)); } while (0)
#define SSM_XMM(src, g_) do { _Pragma("unroll") for (int i_ = 0; i_ < 4; ++i_) acc = __builtin_amdgcn_mfma_f32_32x32x16_bf16(src[i_], pm[4 * (g_) + i_], acc, 0, 0, 0); } while (0)
#pragma unroll
          for (int g4 = 0; g4 < 4; ++g4) { SSM_XLD(fa, g4); __builtin_amdgcn_sched_barrier(0); SSM_XMM(fa, g4); __builtin_amdgcn_sched_barrier(0); }
#undef SSM_XLD
#undef SSM_XMM
#pragma unroll
          for (int r = 0; r < 16; ++r) XL[(32 * rb1 + crow(r, hi)) * 128 + 32 * cb1 + r32] = acc[r]; }
        bf16x8 qf[8];
#pragma unroll
        for (int ks = 0; ks < 8; ++ks) qf[ks] = *(const bf16x8*)(Tp + 256 + 16 * ks);
        __syncthreads();
        if (wid == 0) {
            for (int c0 = 0; c0 < 64; c0 += 8) {
                float xr[8], xi[8];
#pragma unroll
                for (int j = 0; j < 8; ++j) { xr[j] = XL[(c0 + j) * 128 + lane]; xi[j] = XL[(c0 + j) * 128 + 64 + lane]; }
#pragma unroll
                for (int j = 0; j < 8; ++j) {
                    *(LAS unsigned short*)(XI + (c0 + j) * 272 + lane * 2) = (unsigned short)(cvt_pk_bf16(sr, 0.f) & 0xffffu);
                    *(LAS unsigned short*)(XI + (c0 + j) * 272 + 128 + lane * 2) = (unsigned short)(cvt_pk_bf16(si, 0.f) & 0xffffu);
                    const float nr = a16r * sr - a16i * si + xr[j], ni = a16r * si + a16i * sr + xi[j];
                    sr = nr; si = ni;
                }
            }
        }
        __syncthreads();
        { f32x16 acc[2];
#pragma unroll
          for (int rb = 0; rb < 2; ++rb)
#pragma unroll
            for (int r = 0; r < 16; ++r) acc[rb][r] = 0.f;
          LAS const unsigned char* ya = UQ + r32 * 528 + 16 * hi;
          LAS const unsigned char* yx = XI + r32 * 272 + 16 * hi;
          bf16x8 fa[4];
#define SSM_YLD(dst, g_) do { _Pragma("unroll") for (int i_ = 0; i_ < 2; ++i_) _Pragma("unroll") for (int rb = 0; rb < 2; ++rb) { const int ks_ = 2 * (g_) + i_; \
              dst[2 * i_ + rb] = (ks_ < 16) ? *(LAS const bf16x8*)(ya + rb * (32 * 528) + 32 * ks_) : *(LAS const bf16x8*)(yx + rb * (32 * 272) + 32 * (ks_ - 16)); } } while (0)
#define SSM_YMM(src, g_) do { _Pragma("unroll") for (int i_ = 0; i_ < 2; ++i_) _Pragma("unroll") for (int rb = 0; rb < 2; ++rb) { const int ks_ = 2 * (g_) + i_; \
              acc[rb] = __builtin_amdgcn_mfma_f32_32x32x16_bf16(src[2 * i_ + rb], (ks_ < 16) ? tq[ks_ & 15] : qf[ks_ & 7], acc[rb], 0, 0, 0); } } while (0)
#pragma unroll
          for (int g2 = 0; g2 < 12; ++g2) { SSM_YLD(fa, g2); __builtin_amdgcn_sched_barrier(0); SSM_YMM(fa, g2); __builtin_amdgcn_sched_barrier(0); }
#undef SSM_YLD
#undef SSM_YMM
          LAS unsigned short* YS = (LAS unsigned short*)XL;
#pragma unroll
          for (int rb = 0; rb < 2; ++rb)
#pragma unroll
            for (int r = 0; r < 16; ++r) { const int c = 32 * rb + crow(r, hi);
                const float gv = gelu_tanh(acc[rb][r]);
                YS[c * 256 + 32 * wid + r32] = (unsigned short)(cvt_pk_bf16(gv, 0.f) & 0xffffu); } }
        __syncthreads();
        if (do_store) {
#pragma unroll
        for (int j = 0; j < 4; ++j) { const int id = j * 512 + tid, c = id >> 5, pos = id & 31, tau = pos >> 1, h8 = (pos & 1) * 8;
            const u32x4 v = *(LAS const u32x4*)((LAS const unsigned char*)XL + c * 512 + pos * 16);
            *(u32x4*)(QKVU + ((size_t)b * SEQ + (size_t)(64 * qi + c) * 16 + tau) * DIN + 3072 + g * HGC + h8) = v; }
        }
        __syncthreads();
    }
}

#define XB_TMO      128
#define XB_XCNT(j)  (256  + 64 * (j))
#define XB_XSUB(j)  (1280 + 64 * (j))
#define XB_XGEN(j)  (2304 + 64 * (j))
#define XB_TOP      3328
#define XB_TOPGEN   3392
#define XCD_BAR_WORDS 3456
#define XB_SPIN_CAP (1u << 18)
__device__ __forceinline__ unsigned xb_ld(unsigned* p)              { return __hip_atomic_load(p, __ATOMIC_RELAXED, __HIP_MEMORY_SCOPE_AGENT); }
__device__ __forceinline__ unsigned xb_add(unsigned* p, unsigned v) { return __hip_atomic_fetch_add(p, v, __ATOMIC_RELAXED, __HIP_MEMORY_SCOPE_AGENT); }
__device__ __forceinline__ unsigned xb_xcc_id() { return (unsigned)__builtin_amdgcn_s_getreg((3 << 11) | 20) & 0xFu; }
#define XB_SPIN(cond, bar) do { unsigned _sp = 0; while (cond) { __builtin_amdgcn_s_sleep(1); \
    if ((++_sp & 255u) == 0u) { if (xb_ld(&(bar)[XB_TMO])) break; if (_sp > XB_SPIN_CAP) { atomicAdd(&(bar)[XB_TMO], 1u); break; } } } } while (0)
struct XcdBarrier { unsigned* bar; unsigned x; volatile LAS unsigned* st; };
__device__ __forceinline__ XcdBarrier xcd_barrier_post(unsigned* bar, volatile LAS unsigned* st) {
    XcdBarrier b; b.bar = bar; b.x = xb_xcc_id(); b.st = st;
    if (threadIdx.x == 0) (void)xb_add(&bar[XB_XCNT(b.x)], 1u);
    return b;
}
__device__ __forceinline__ void xcd_barrier_complete(unsigned* bar, unsigned x, unsigned& nloc, unsigned& nx) {
    const unsigned G = gridDim.x * gridDim.y * gridDim.z;
    unsigned sum, cnt, mine, sp = 0u;
    for (;;) {
        sum = 0u; cnt = 0u; mine = 0u;
#pragma unroll
        for (unsigned j = 0; j < 16; ++j) { const unsigned c = xb_ld(&bar[XB_XCNT(j)]); sum += c; cnt += (c > 0u) ? 1u : 0u; mine = (j == x) ? c : mine; }
        if (sum == G) break;
        __builtin_amdgcn_s_sleep(1);
        if ((++sp & 255u) == 0u) { if (xb_ld(&bar[XB_TMO])) break; if (sp > XB_SPIN_CAP) { atomicAdd(&bar[XB_TMO], 1u); break; } }
    }
    nloc = mine > 0u ? mine : 1u; nx = cnt > 0u ? cnt : 1u;
}
__device__ __forceinline__ void xcd_barrier(const XcdBarrier& b) {
    asm volatile("s_waitcnt vmcnt(0)" ::: "memory");
    __syncthreads();
    if (threadIdx.x == 0) {
        unsigned* bar = b.bar;
        __builtin_amdgcn_s_waitcnt(0);
        unsigned nloc = b.st[0], nx = b.st[1];
        if (nloc == 0u) { xcd_barrier_complete(bar, b.x, nloc, nx); b.st[0] = nloc; b.st[1] = nx; }
        const unsigned old = xb_add(&bar[XB_XSUB(b.x)], 1u);
        const unsigned gen = old / nloc;
        if (old + 1u == (gen + 1u) * nloc) {
            __builtin_amdgcn_fence(__ATOMIC_RELEASE, "agent");
            asm volatile("s_waitcnt vmcnt(0)" ::: "memory");
            const unsigned og = xb_add(&bar[XB_TOP], 1u);
            const unsigned tg = og / nx;
            if (og + 1u == (tg + 1u) * nx) xb_add(&bar[XB_TOPGEN], 1u);
            else XB_SPIN(xb_ld(&bar[XB_TOPGEN]) == tg, bar);
            __builtin_amdgcn_fence(__ATOMIC_ACQUIRE, "agent");
            xb_add(&bar[XB_XGEN(b.x)], 1u);
            asm volatile("s_waitcnt vmcnt(0)" ::: "memory");
        } else {
            XB_SPIN(xb_ld(&bar[XB_XGEN(b.x)]) == gen, bar);
            __builtin_amdgcn_fence(__ATOMIC_ACQUIRE, "agent");
            asm volatile("s_waitcnt vmcnt(0)" ::: "memory");
        }
    }
    __syncthreads();
}

static __device__ const unsigned att_tab[64] = {173134591u,155831038u,138527485u,2021260023u,1886515958u,1751771893u,1617027836u,1482283764u,3368634095u,3233891822u,3099149549u,2964407276u,2829667815u,2694925542u,2560183269u,120801252u,2425443551u,2290701278u,103960541u,1345277660u,2155961303u,1210996694u,1076713173u,942429652u,808148943u,673865422u,338124237u,321281228u,304441031u,287598022u,4163069125u,4028785604u,469331391u,452029630u,434727869u,88041404u,400651447u,383349686u,71200693u,54357684u,366050223u,37517230u,20674221u,3831212u,540515239u,406229926u,271944613u,255099812u,240827295u,223523742u,206220189u,188916636u,3900365719u,3765621654u,3630877589u,3496133524u,530250639u,512947086u,495643533u,478339980u,968523655u,833781382u,699039109u,564296836u};

__global__ void __launch_bounds__(512, 2) mk_fwd(Args args) {
    extern __shared__ __attribute__((aligned(16))) unsigned char lds_raw[];
    LAS unsigned char* lds = (LAS unsigned char*)lds_raw;
    cg::grid_group grid = cg::this_grid();
    const int tid = threadIdx.x, lane = tid & 63, wave = __builtin_amdgcn_readfirstlane(tid >> 6);
    const int G = gridDim.x, bx = blockIdx.x;
    const int vcu = (G % 8 == 0) ? (bx % 8) * (G / 8) + bx / 8 : bx;
    unsigned char* ws = args.ws;
    const float* x = args.in[0];
    float* out = args.out;
    float* ss1 = (float*)(ws + WS_SS1); float* ss2 = (float*)(ws + WS_SS2); float* ss3 = (float*)(ws + WS_SS3); float* A16 = (float*)(ws + WS_A16);
    bf16_t* Wgu1 = (bf16_t*)(ws + WS_WGU1); bf16_t* Wd1 = (bf16_t*)(ws + WS_WD1); bf16_t* Win = (bf16_t*)(ws + WS_WIN); bf16_t* Wglu = (bf16_t*)(ws + WS_WGLU);
    bf16_t* Wout = (bf16_t*)(ws + WS_WOUT); bf16_t* Wgu2 = (bf16_t*)(ws + WS_WGU2); bf16_t* Wd2 = (bf16_t*)(ws + WS_WD2);
    bf16_t* TQ = (bf16_t*)(ws + WS_TQ); bf16_t* PM = (bf16_t*)(ws + WS_PM); bf16_t* XN = (bf16_t*)(ws + WS_XN); bf16_t* ACT = (bf16_t*)(ws + WS_ACT);
    bf16_t* QKVU = (bf16_t*)(ws + WS_QKVU); bf16_t* UP = (bf16_t*)(ws + WS_UP); float* KN = (float*)(ws + WS_KN);
    const int lo = args.ph_lo, hi_ph = args.ph_hi;
#define IN(k) (lo <= (k) && (k) < hi_ph)
    volatile LAS unsigned* bst = (volatile LAS unsigned*)(lds + 131072 + 64);
    if (tid < 4) bst[tid] = 0u;
    __syncthreads();
    unsigned* barw = (unsigned*)(ws + WS_BAR);
    if (args.ph_lo < 0) grid.sync();
    XcdBarrier xbar = xcd_barrier_post(barw, bst);
#define SEAM(k) do { if (IN(k) && IN((k) + 1)) xcd_barrier(xbar); } while (0)

    if (IN(0)) {
        { LAS float* scr = (LAS float*)(lds + wave * 8448);
          const int gw = vcu * 8 + wave, NGW = G * 8;
          constexpr int I_F = (DM / 64) * (DFF / 32), I_D = (DFF / 64) * (DM / 32), I_IN = (DM / 64) * (DIN / 32), I_GL = (1024 / 64) * (1024 / 32), I_O = (DM / 64) * (DM / 32);
          constexpr int NITEMS = 4 * I_F + 2 * I_D + I_IN + I_GL + I_O;
          for (int it = gw; it < (PROBE == 3 ? 2 : 1) * NITEMS; it += NGW) {
              int r = it % NITEMS;
              if (r < I_F) { tr_item(args.in[2], DM, DFF, Wgu1, nullptr, 1, scr, r, lane); continue; } r -= I_F;
              if (r < I_F) { tr_item(args.in[3], DM, DFF, Wgu1, nullptr, 2, scr, r, lane); continue; } r -= I_F;
              if (r < I_D) { tr_item(args.in[4], DFF, DM, Wd1, nullptr, 0, scr, r, lane); continue; } r -= I_D;
              if (r < I_IN) { tr_item(args.in[6], DM, DIN, Win, args.in[5], 0, scr, r, lane); continue; } r -= I_IN;
              if (r < I_GL) { tr_item(args.in[20], 1024, 1024, Wglu, nullptr, 0, scr, r, lane); continue; } r -= I_GL;
              if (r < I_O) { tr_item(args.in[22], DM, DM, Wout, nullptr, 0, scr, r, lane); continue; } r -= I_O;
              if (r < I_F) { tr_item(args.in[24], DM, DFF, Wgu2, args.in[23], 1, scr, r, lane); continue; } r -= I_F;
              if (r < I_F) { tr_item(args.in[25], DM, DFF, Wgu2, args.in[23], 2, scr, r, lane); continue; } r -= I_F;
              tr_item(args.in[26], DFF, DM, Wd2, nullptr, 0, scr, r, lane);
          }
          const float* g1 = args.in[1];
          f32x4 g1v[8];
#pragma unroll
          for (int j = 0; j < 8; ++j) g1v[j] = *((const f32x4*)g1 + lane + 64 * j);
          for (int m2 = gw; m2 < (PROBE == 8 ? 2 : 1) * MTOK; m2 += NGW) {
              const int m = m2 % MTOK;
              const f32x4* xr = (const f32x4*)(x + (size_t)m * DM) + lane;
              f32x4 v[8]; float s = 0.f;
#pragma unroll
              for (int j = 0; j < 8; ++j) { v[j] = xr[64 * j]; s += (v[j][0] * v[j][0] + v[j][1] * v[j][1]) + (v[j][2] * v[j][2] + v[j][3] * v[j][3]); }
              const float rs = rsqrtf(wave_sum(s) * (1.0f / DM) + NORM_EPS);
              u32x2* o8 = (u32x2*)(XN + (size_t)m * DM) + lane;
#pragma unroll
              for (int j = 0; j < 8; ++j) { const f32x4 gg = g1v[j]; u32x2 w; w.x = cvt_pk_bf16(v[j][0] * rs * gg[0], v[j][1] * rs * gg[1]); w.y = cvt_pk_bf16(v[j][2] * rs * gg[2], v[j][3] * rs * gg[3]); o8[64 * j] = w; }
          }
        }
        for (int i = bx * 512 + tid; i < 3 * MTOK; i += G * 512) ((float*)(ws + WS_SS1))[i] = 0.f;
        for (int i = bx * 512 + tid; i < BATCH * 16 * SEQ; i += G * 512) KN[i] = 0.f;
        __syncthreads();
        if (bx < 256) {
            const int g = bx & 63, part = bx >> 6;
            LAS float* pwr = (LAS float*)lds; LAS float* pwi = pwr + 17 * 64; LAS float* bbr = pwi + 17 * 64; LAS float* bbi = bbr + 1024; LAS float* crr = bbi + 1024; LAS float* cii = crr + 1024; LAS float* Kd = cii + 1024;
            const float* lam_re = args.in[12] + g * NST; const float* lam_im = args.in[13] + g * NST;
            const float dt = expf(args.in[14][g]);
            for (int idx = tid; idx < 17 * 64; idx += 512) { const int d = idx >> 6, p = idx & 63; const float lr = lam_re[p], li = lam_im[p];
                const float mag = expf((float)d * (lr * dt)), ang = (float)d * (li * dt); pwr[idx] = mag * cosf(ang); pwi[idx] = mag * sinf(ang); }
            for (int idx = tid; idx < 1024; idx += 512) { const int p = idx >> 4; const float lr = lam_re[p], li = lam_im[p];
                const float mag = expf(lr * dt), abr = mag * cosf(li * dt), abi = mag * sinf(li * dt), den = lr * lr + li * li;
                const float fr_ = ((abr - 1.0f) * lr + abi * li) / den, fi_ = (abi * lr - (abr - 1.0f) * li) / den;
                const float br = args.in[15][(size_t)g * 1024 + idx], bi = args.in[16][(size_t)g * 1024 + idx];
                bbr[idx] = fr_ * br - fi_ * bi; bbi[idx] = fr_ * bi + fi_ * br;
                crr[idx] = args.in[17][(size_t)g * 1024 + idx]; cii[idx] = args.in[18][(size_t)g * 1024 + idx]; }
            __syncthreads();
            {
              const int d = tid >> 5, h = (tid >> 1) & 15, hb = (tid & 1) * 8; float acc8[8];
#pragma unroll
              for (int j = 0; j < 8; ++j) acc8[j] = 0.f;
              for (int p = 0; p < 64; ++p) { const float cr = crr[h * 64 + p], ci = cii[h * 64 + p], pr = pwr[d * 64 + p], pi = pwi[d * 64 + p];
                  const float er = cr * pr - ci * pi, ei = cr * pi + ci * pr;
                  const f32x4 br0 = *(LAS const f32x4*)(bbr + p * 16 + hb), br1 = *(LAS const f32x4*)(bbr + p * 16 + hb + 4), bi0 = *(LAS const f32x4*)(bbi + p * 16 + hb), bi1 = *(LAS const f32x4*)(bbi + p * 16 + hb + 4);
#pragma unroll
                  for (int j = 0; j < 4; ++j) { acc8[j] += er * br0[j] - ei * bi0[j]; acc8[4 + j] += er * br1[j] - ei * bi1[j]; } }
#pragma unroll
              for (int j = 0; j < 8; ++j) { float a = acc8[j]; if (d == 0 && h == hb + j) a += args.in[19][g * HGC + h]; Kd[d * 256 + h * 16 + hb + j] = a; } }
            __syncthreads();
            bf16_t* TQg = TQ + (size_t)g * 256 * 384; bf16_t* PMg = PM + (size_t)g * 128 * 256;
            for (int ck = tid; ck < 64 * 48; ck += 512) { const int row = 64 * part + ck / 48, c8 = (ck % 48) * 8, tau = row >> 4, h = row & 15; float v[8];
                if (c8 < 256) { const int sg = c8 >> 4, h2 = c8 & 15;
                    if (tau >= sg) { const f32x4 k0 = *(LAS const f32x4*)(Kd + (tau - sg) * 256 + h * 16 + h2), k1 = *(LAS const f32x4*)(Kd + (tau - sg) * 256 + h * 16 + h2 + 4);
#pragma unroll
                        for (int j = 0; j < 4; ++j) { v[j] = k0[j]; v[4 + j] = k1[j]; } }
                    else {
#pragma unroll
                        for (int j = 0; j < 8; ++j) v[j] = 0.f; } }
                else { const bool im = (c8 >= 320); const int p = c8 - (im ? 320 : 256);
                    const f32x4 cr0 = *(LAS const f32x4*)(crr + h * 64 + p), cr1 = *(LAS const f32x4*)(crr + h * 64 + p + 4), ci0 = *(LAS const f32x4*)(cii + h * 64 + p), ci1 = *(LAS const f32x4*)(cii + h * 64 + p + 4);
                    const f32x4 pr0 = *(LAS const f32x4*)(pwr + (tau + 1) * 64 + p), pr1 = *(LAS const f32x4*)(pwr + (tau + 1) * 64 + p + 4), pi0 = *(LAS const f32x4*)(pwi + (tau + 1) * 64 + p), pi1 = *(LAS const f32x4*)(pwi + (tau + 1) * 64 + p + 4);
#pragma unroll
                    for (int j = 0; j < 4; ++j) { v[j] = im ? -(cr0[j] * pi0[j] + ci0[j] * pr0[j]) : (cr0[j] * pr0[j] - ci0[j] * pi0[j]);
                                                  v[4 + j] = im ? -(cr1[j] * pi1[j] + ci1[j] * pr1[j]) : (cr1[j] * pr1[j] - ci1[j] * pi1[j]); } }
                u32x4 w; w.x = cvt_pk_bf16(v[0], v[1]); w.y = cvt_pk_bf16(v[2], v[3]); w.z = cvt_pk_bf16(v[4], v[5]); w.w = cvt_pk_bf16(v[6], v[7]);
                *(u32x4*)(TQg + (size_t)row * 384 + c8) = w; }
            for (int ck = tid; ck < 32 * 32; ck += 512) { const int row = 32 * part + (ck >> 5), c8 = (ck & 31) * 8, sg = c8 >> 4, h2 = c8 & 15, p = row & 63;
                const float pr = pwr[(15 - sg) * 64 + p], pi = pwi[(15 - sg) * 64 + p];
                const f32x4 br0 = *(LAS const f32x4*)(bbr + p * 16 + h2), br1 = *(LAS const f32x4*)(bbr + p * 16 + h2 + 4), bi0 = *(LAS const f32x4*)(bbi + p * 16 + h2), bi1 = *(LAS const f32x4*)(bbi + p * 16 + h2 + 4);
                float v[8];
#pragma unroll
                for (int j = 0; j < 4; ++j) { v[j] = (row < 64) ? (pr * br0[j] - pi * bi0[j]) : (pr * bi0[j] + pi * br0[j]); v[4 + j] = (row < 64) ? (pr * br1[j] - pi * bi1[j]) : (pr * bi1[j] + pi * br1[j]); }
                u32x4 w; w.x = cvt_pk_bf16(v[0], v[1]); w.y = cvt_pk_bf16(v[2], v[3]); w.z = cvt_pk_bf16(v[4], v[5]); w.w = cvt_pk_bf16(v[6], v[7]);
                *(u32x4*)(PMg + (size_t)row * 256 + c8) = w; }
            if (part == 0 && tid < 64) { A16[(g * NST + tid) * 2] = pwr[16 * 64 + tid]; A16[(g * NST + tid) * 2 + 1] = pwi[16 * 64 + tid]; }
        }
        __syncthreads();
    }
    SEAM(0);
#if PROBE == 4
    for (int i = 0; i < 20; ++i) grid.sync();
#endif
    for (int rep1 = 0; rep1 < (PROBE == 5 ? 2 : 1); ++rep1)
    if (IN(1)) {
        pg8::Gemm g{XN, Wgu1, MTOK, 2 * DFF, DM, DM, DM}; pg8::StaticOrder S; S.init(MTOK, 2 * DFF, G, bx);
        pg8::EpiSwiGLU E{ACT, DFF, nullptr};
        pg8::gemm_phase<pg8::EpiSwiGLU, pg8::StaticOrder>(lds, g, S, E);
    }
    SEAM(1);
    if (IN(2)) {
        pg8::Gemm g{ACT, Wd1, MTOK, DM, DFF, DFF, DFF}; pg8::StaticOrder S; S.init(MTOK, DM, G, bx);
        pg8::EpiResid E{x, out, XN, ss1, 0.5f, (LAS float*)(lds + 131072 + 4096)};
        pg8::gemm_phase<pg8::EpiResid, pg8::StaticOrder>(lds, g, S, E);
    }
    SEAM(2);
    for (int rep3 = 0; rep3 < (PROBE == 7 ? 2 : 1); ++rep3)
    if (IN(3)) {
        pg8::Gemm g{XN, Win, MTOK, DIN, DM, DM, DM}; pg8::StaticOrder S; S.init(MTOK, DIN, G, bx);
        pg8::EpiWin E{QKVU, UP, ss1, KN, (LAS float*)(lds + 131072 + 8192)};
        pg8::gemm_phase<pg8::EpiWin, pg8::StaticOrder>(lds, g, S, E);
    }
    SEAM(3);
    if (IN(4)) {
        float lam;
        { const float a = wave_sum(args.in[7][lane] * args.in[8][lane]), c = wave_sum(args.in[9][lane] * args.in[10][lane]); lam = expf(a) - expf(c) + LAMBDA_INIT; }
        if (tid < 128) ((LAS float*)(lds + 131072 + 512))[tid] = args.in[11][tid];
        __syncthreads();
        for (int cu = vcu; cu < 256; cu += G) {
            const int b = cu >> 6; const unsigned e = att_tab[cu & 63];
            for (int ui = 0; ui < 4; ++ui) {
                const unsigned u8 = (e >> (8 * ui)) & 255u;
                attn_unit(b, (int)(u8 & 7u), (int)(u8 >> 3), QKVU, QKVU, DIN, KN, lds, lam, args.in[11]);
            }
        }
        if (bx < 256) {
            ssm_unit(bx >> 6, bx & 63, UP, TQ, PM, A16, QKVU, lds, true);
#if PROBE == 2
            ssm_unit(bx >> 6, bx & 63, UP, TQ, PM, A16, QKVU, lds, true);
#endif
#if PROBE == 9
            ssm_unit(bx >> 6, bx & 63, UP, TQ, PM, A16, QKVU, lds, false);
#endif
        }
    }
    SEAM(4);
    for (int rep5 = 0; rep5 < (PROBE == 6 ? 2 : 1); ++rep5)
    if (IN(5)) {
        pg8::Gemm g{QKVU + 3072, Wglu, MTOK, 1024, 1024, DIN, 1024}; pg8::StaticOrder S; S.init(MTOK, 1024, G, bx);
        pg8::EpiGlu E{QKVU, args.in[21]};
        pg8::gemm_phase<pg8::EpiGlu, pg8::StaticOrder>(lds, g, S, E);
    }
    SEAM(5);
    if (IN(6)) {
        pg8::Gemm g{QKVU, Wout, MTOK, DM, DM, DIN, DM}; pg8::StaticOrder S; S.init(MTOK, DM, G, bx);
        pg8::EpiResid E{out, out, XN, ss2, 1.0f, (LAS float*)(lds + 131072 + 4096)};
        pg8::gemm_phase<pg8::EpiResid, pg8::StaticOrder>(lds, g, S, E);
    }
    SEAM(6);
    if (IN(7)) {
        pg8::Gemm g{XN, Wgu2, MTOK, 2 * DFF, DM, DM, DM}; pg8::StaticOrder S; S.init(MTOK, 2 * DFF, G, bx);
        pg8::EpiSwiGLU E{ACT, DFF, ss2};
        pg8::gemm_phase<pg8::EpiSwiGLU, pg8::StaticOrder>(lds, g, S, E);
    }
    SEAM(7);
    const bool fused_tail = (G == 256);
    if (IN(8)) {
        pg8::Gemm g{ACT, Wd2, MTOK, DM, DFF, DFF, DFF};
        if (fused_tail) {
            pg8::FusedOrder S{bx};
            pg8::EpiResidNorm E{out, out, ss3, (unsigned*)(ws + WS_PCNT), args.in[27], 0.5f, (LAS float*)(lds + 131072 + 4096)};
            pg8::gemm_phase<pg8::EpiResidNorm, pg8::FusedOrder>(lds, g, S, E);
        } else {
            pg8::StaticOrder S; S.init(MTOK, DM, G, bx);
            pg8::EpiResid E{out, out, nullptr, ss3, 0.5f, (LAS float*)(lds + 131072 + 4096)};
            pg8::gemm_phase<pg8::EpiResid, pg8::StaticOrder>(lds, g, S, E);
        }
    }
    if (!fused_tail) SEAM(8);
    if (IN(9) && !fused_tail) {
        const float* gf = args.in[27];
        const int gw = vcu * 8 + wave, NGW = G * 8;
        f32x4 ggv[8];
#pragma unroll
        for (int j = 0; j < 8; ++j) ggv[j] = *((const f32x4*)gf + lane + 64 * j);
        for (int m = gw; m < MTOK; m += NGW) {
            const float rs = rsqrtf(ss3[m] * (1.0f / DM) + NORM_EPS);
            f32x4* xr = (f32x4*)(out + (size_t)m * DM) + lane;
            f32x4 v[8];
#pragma unroll
            for (int j = 0; j < 8; ++j) v[j] = xr[64 * j];
#pragma unroll
            for (int j = 0; j < 8; ++j) xr[64 * j] = v[j] * rs * ggv[j];
        }
    }
#undef IN
#undef SEAM
}

#ifndef MK_N_LAUNCHES
#define MK_N_LAUNCHES 1
#endif
constexpr int N_PHASES = 10;

extern "C" void kernel_launch(void* const* d_in, const int* in_sizes, int n_in, void* d_out, int out_size, void* d_ws, size_t ws_size, hipStream_t stream) {
    static int grid = 0;
    if (grid == 0) {
        if (n_in != 28 || ws_size < WS_END) { fprintf(stderr, "kernel_launch: unexpected inputs (n_in %d, ws %zu)\n", n_in, ws_size); grid = -1; return; }
        int dev = 0, cus = 0, per_cu = 0;
        (void)hipGetDevice(&dev);
        (void)hipDeviceGetAttribute(&cus, hipDeviceAttributeMultiprocessorCount, dev);
        (void)hipFuncSetAttribute((const void*)mk_fwd, hipFuncAttributeMaxDynamicSharedMemorySize, LDS_BYTES);
        (void)hipOccupancyMaxActiveBlocksPerMultiprocessor(&per_cu, (const void*)mk_fwd, 512, LDS_BYTES);
        if (per_cu < 1) { fprintf(stderr, "kernel_launch: occupancy query reports %d blocks per CU\n", per_cu); per_cu = 1; }
        (void)hipGetLastError();
        grid = cus;
    }
    if (grid < 0) return;
    if (hipMemsetAsync((char*)d_ws + WS_BAR, 0, 16384 + 64 * 256, stream) != hipSuccess) { fprintf(stderr, "kernel_launch: memset of the barrier words failed\n"); return; }
    Args a{};
    for (int i = 0; i < 28; ++i) a.in[i] = (const float*)d_in[i];
    a.out = (float*)d_out; a.ws = (unsigned char*)d_ws;
#if MK_N_LAUNCHES == 1
    a.ph_lo = 0; a.ph_hi = N_PHASES;
    void* kargs[] = {&a};
    hipError_t e = hipLaunchCooperativeKernel((const void*)mk_fwd, dim3(grid), dim3(512), kargs, LDS_BYTES, stream);
    if (e != hipSuccess) fprintf(stderr, "cooperative launch failed: %s (grid %d)\n", hipGetErrorString(e), grid);
#else
    for (int p = 0; p < N_PHASES; ++p) { a.ph_lo = p; a.ph_hi = p + 1; hipLaunchKernelGGL(mk_fwd, dim3(grid), dim3(512), LDS_BYTES, stream, a); }
#endif
}
```
